# Optimizing an MI355X kernel written in HIP

```python
import math
import jax
import jax.numpy as jnp
from jax import lax
import numpy as np

D_MODEL = 2048
BATCH = 1
SEQ = 8192
DEPTH = 2

GRID_W = 64
CTX_LEN = 256
CHUNK = 128
Q_BLOCK = 128
ROPE_BASE = 10000.0
EPS = 1e-6
N_MOD = 6

D_SGU = D_MODEL // 4
D_RET = D_MODEL // 4
D_DIFF = D_MODEL // 2
D_MIX = D_SGU + D_RET + D_DIFF
SGU_DIM = 128
SGU_GROUPS = D_SGU // SGU_DIM
RET_DK = 128
RET_DV = 128
RET_HEADS = D_RET // RET_DV
DIFF_DV = 128
DIFF_DQK = DIFF_DV // 2
DIFF_HEADS = D_DIFF // DIFF_DV
D_FF = ((8 * D_MODEL // 3 + 255) // 256) * 256

IN_SIZES = (D_SGU, D_SGU, RET_HEADS * RET_DK, RET_HEADS * RET_DK, D_RET, D_RET, D_DIFF, D_DIFF, D_DIFF)
D_IN = 2 * D_SGU + 2 * RET_HEADS * RET_DK + 2 * D_RET + 3 * D_DIFF
P_SGU_U, P_SGU_V, P_RET_Q, P_RET_K, P_RET_V, P_RET_G, P_DIFF_Q, P_DIFF_K, P_DIFF_V = range(9)
CTX_KV_PARTS = (P_RET_K, P_RET_V, P_DIFF_K, P_DIFF_V)

kernel_name = 'hybrid_sgu_retention_diffattn_dit'


def rms_norm(x, g=None):
    xf = x.astype(jnp.float32)
    y = xf * lax.rsqrt(jnp.mean(xf * xf, axis=-1, keepdims=True) + EPS)
    if g is not None:
        y = y * g.astype(jnp.float32)
    return y.astype(x.dtype)


def modulate(x, g, shift, scale):
    return rms_norm(x, g) * (1 + scale) + shift


def split_in(z):
    offs = []
    acc = 0
    for s in IN_SIZES[:-1]:
        acc += s
        offs.append(acc)
    return jnp.split(z, offs, axis=-1)


def heads(z, n_heads):
    b, l, _ = z.shape
    return z.reshape(b, l, n_heads, -1).transpose(0, 2, 1, 3)


def merge_heads(z):
    b, h, l, d = z.shape
    return z.transpose(0, 2, 1, 3).reshape(b, l, h * d)


def flip(z):
    return z[:, :, ::-1]


def rope_1d(x, pos):
    half = x.shape[-1] // 2
    freqs = ROPE_BASE ** (-jnp.arange(half, dtype=jnp.float32) / half)
    ang = pos.astype(jnp.float32)[:, None] * freqs[None, :]
    cos, sin = jnp.cos(ang), jnp.sin(ang)
    xf = x.astype(jnp.float32)
    x1, x2 = xf[..., :half], xf[..., half:]
    return jnp.concatenate([x1 * cos - x2 * sin, x1 * sin + x2 * cos], axis=-1).astype(x.dtype)


def axial_rope(x, rows, cols):
    h = x.shape[-1] // 2
    return jnp.concatenate([rope_1d(x[..., :h], rows), rope_1d(x[..., h:], cols)], axis=-1)


def chunk_sgu(u, v, w_s, b_s):
    b, l, _ = v.shape
    n = l // CHUNK
    vg = rms_norm(v.reshape(b, n, CHUNK, SGU_GROUPS, SGU_DIM))
    mixed = jnp.einsum('gij,bnjgc->bnigc', w_s, vg) + b_s.T[None, None, :, :, None]
    return u * mixed.reshape(b, l, D_SGU)


def retention_chunkwise(q, k, v, log_gamma, s0):
    b, h, l, _ = q.shape
    n = l // CHUNK

    def to_chunks(z):
        return jnp.moveaxis(z.reshape(b, h, n, CHUNK, z.shape[-1]), 2, 0)

    idx = jnp.arange(CHUNK, dtype=jnp.float32)
    lg = log_gamma[:, None]
    rel = idx[:, None] - idx[None, :]
    intra = jnp.where(rel >= 0, jnp.exp(jnp.maximum(rel, 0.0)[None] * log_gamma[:, None, None]), 0.0).astype(q.dtype)
    q_decay = jnp.exp((idx + 1.0)[None, :] * lg).astype(q.dtype)[None, :, :, None]
    k_decay = jnp.exp((CHUNK - 1.0 - idx)[None, :] * lg).astype(q.dtype)[None, :, :, None]
    c_decay = jnp.exp(CHUNK * log_gamma).astype(q.dtype)[None, :, None, None]

    def step(state, chunk):
        qc, kc, vc = chunk
        scores = jnp.einsum('bhid,bhjd->bhij', qc, kc) * intra[None]
        out = jnp.einsum('bhij,bhjv->bhiv', scores, vc) + jnp.einsum('bhid,bhdv->bhiv', qc * q_decay, state)
        state = state * c_decay + jnp.einsum('bhjd,bhjv->bhdv', kc * k_decay, vc)
        return state, out

    _, outs = lax.scan(step, s0.astype(q.dtype), (to_chunks(q), to_chunks(k), to_chunks(v)))
    return jnp.moveaxis(outs, 0, 2).reshape(b, h, l, v.shape[-1])


def retention_final_state(k, v, log_gamma):
    l = k.shape[2]
    w = jnp.exp((l - 1.0 - jnp.arange(l, dtype=jnp.float32))[None, :] * log_gamma[:, None]).astype(k.dtype)
    return jnp.einsum('bhjd,hj,bhjv->bhdv', k, w, v)


def retention_mixer(q, k, v, g, qc, kc, vc, gc, lg_f, lg_b, rows, cols):
    scale = RET_DK ** -0.5
    q = axial_rope(heads(q, RET_HEADS), rows, cols)
    k = axial_rope(heads(k, RET_HEADS), rows, cols) * scale
    v = heads(v, RET_HEADS)
    kc = heads(kc, RET_HEADS) * scale
    vc = heads(vc, RET_HEADS)
    s_f = retention_final_state(kc, vc, lg_f)
    s_b = retention_final_state(flip(kc), flip(vc), lg_b)
    o = retention_chunkwise(q, k, v, lg_f, s_f) + flip(retention_chunkwise(flip(q), flip(k), flip(v), lg_b, s_b))
    y = merge_heads(rms_norm(o)) * jax.nn.silu(g)
    if qc is None:
        return y, None
    qc = heads(qc, RET_HEADS)
    zero = jnp.zeros_like(s_f)
    oc = retention_chunkwise(qc, kc, vc, lg_f, zero) + flip(retention_chunkwise(flip(qc), flip(kc), flip(vc), lg_b, zero))
    yc = merge_heads(rms_norm(oc)) * jax.nn.silu(gc)
    return y, yc


def diff_attend(q1, q2, k1, k2, v, lam):
    scale = DIFF_DQK ** -0.5
    s1 = jnp.einsum('bhqd,bhkd->bhqk', q1, k1).astype(jnp.float32) * scale
    s2 = jnp.einsum('bhqd,bhkd->bhqk', q2, k2).astype(jnp.float32) * scale
    p = jax.nn.softmax(s1, axis=-1) - lam * jax.nn.softmax(s2, axis=-1)
    return jnp.einsum('bhqk,bhkv->bhqv', p.astype(v.dtype), v)


def diff_attention_mixer(q, k, v, qc, kc, vc, lam, lam_init, subln_g, rows, cols):
    b, l, _ = q.shape

    def maps(z, rope):
        zh = heads(z, DIFF_HEADS)
        z1, z2 = zh[..., :DIFF_DQK], zh[..., DIFF_DQK:]
        if rope:
            z1, z2 = axial_rope(z1, rows, cols), axial_rope(z2, rows, cols)
        return z1, z2

    q1, q2 = maps(q, True)
    k1, k2 = maps(k, True)
    kc1, kc2 = maps(kc, False)
    vch = heads(vc, DIFF_HEADS)
    key1 = jnp.concatenate([k1, kc1], axis=2)
    key2 = jnp.concatenate([k2, kc2], axis=2)
    val = jnp.concatenate([heads(v, DIFF_HEADS), vch], axis=2)
    nb = l // Q_BLOCK

    def blocks(z):
        return jnp.moveaxis(z.reshape(b, DIFF_HEADS, nb, Q_BLOCK, z.shape[-1]), 2, 0)

    o = lax.map(lambda qs: diff_attend(qs[0], qs[1], key1, key2, val, lam), (blocks(q1), blocks(q2)))
    o = jnp.moveaxis(o, 0, 2).reshape(b, DIFF_HEADS, l, DIFF_DV)
    y = merge_heads(rms_norm(o, subln_g) * (1.0 - lam_init))
    if qc is None:
        return y, None
    qc1, qc2 = maps(qc, False)
    oc = diff_attend(qc1, qc2, kc1, kc2, vch, lam)
    yc = merge_heads(rms_norm(oc, subln_g) * (1.0 - lam_init))
    return y, yc


def swiglu(h, wg, wu, wd):
    return (jax.nn.silu(h @ wg) * (h @ wu)) @ wd


def setup_inputs(seed: int = 0) -> dict:
    key = jax.random.key(seed)
    ks = jax.random.split(key, 24)
    f32 = jnp.float32

    def nrm(k, shape, scale):
        return jax.random.normal(k, shape, f32) * scale

    gamma = 1.0 - jnp.exp(jnp.linspace(math.log(1.0 / 32), math.log(1.0 / 512), RET_HEADS))
    base_logit = jnp.log(gamma) - jnp.log1p(-gamma)
    return {
        'x': nrm(ks[0], (BATCH, SEQ, D_MODEL), 1.0),
        'c': nrm(ks[1], (BATCH, D_MODEL), 1.0),
        'ctx': nrm(ks[2], (BATCH, CTX_LEN, D_MODEL), 1.0),
        'c_ctx': nrm(ks[3], (D_MODEL,), 1.0),
        'w_ada': nrm(ks[4], (DEPTH, D_MODEL, N_MOD * D_MODEL), 0.5 * D_MODEL ** -0.5),
        'b_ada': nrm(ks[5], (DEPTH, N_MOD * D_MODEL), 0.02),
        'norm1_g': 1.0 + nrm(ks[6], (DEPTH, D_MODEL), 0.02),
        'w_in': nrm(ks[7], (DEPTH, D_MODEL, D_IN), D_MODEL ** -0.5),
        'sgu_w': nrm(ks[8], (DEPTH, SGU_GROUPS, CHUNK, CHUNK), CHUNK ** -0.5),
        'sgu_b': 1.0 + nrm(ks[9], (DEPTH, SGU_GROUPS, CHUNK), 0.02),
        'ret_decay_fwd': base_logit[None, :] + nrm(ks[10], (DEPTH, RET_HEADS), 0.05),
        'ret_decay_bwd': base_logit[None, :] + nrm(ks[11], (DEPTH, RET_HEADS), 0.05),
        'diff_lambda_q1': nrm(ks[12], (DEPTH, DIFF_DQK), 0.1),
        'diff_lambda_k1': nrm(ks[13], (DEPTH, DIFF_DQK), 0.1),
        'diff_lambda_q2': nrm(ks[14], (DEPTH, DIFF_DQK), 0.1),
        'diff_lambda_k2': nrm(ks[15], (DEPTH, DIFF_DQK), 0.1),
        'diff_subln_g': 1.0 + nrm(ks[16], (DEPTH, DIFF_DV), 0.02),
        'w_out': nrm(ks[17], (DEPTH, D_MIX, D_MODEL), D_MIX ** -0.5),
        'norm2_g': 1.0 + nrm(ks[18], (DEPTH, D_MODEL), 0.02),
        'w_gate': nrm(ks[19], (DEPTH, D_MODEL, D_FF), D_MODEL ** -0.5),
        'w_up': nrm(ks[20], (DEPTH, D_MODEL, D_FF), D_MODEL ** -0.5),
        'w_down': nrm(ks[21], (DEPTH, D_FF, D_MODEL), D_FF ** -0.5),
        'final_g': 1.0 + nrm(ks[22], (D_MODEL,), 0.02),
    }


def reference(x, c, ctx, c_ctx, w_ada, b_ada, norm1_g, w_in, sgu_w, sgu_b, ret_decay_fwd, ret_decay_bwd,
              diff_lambda_q1, diff_lambda_k1, diff_lambda_q2, diff_lambda_k2, diff_subln_g, w_out, norm2_g,
              w_gate, w_up, w_down, final_g):
    seq_len = x.shape[1]
    n_rows = seq_len // GRID_W
    rows = jnp.repeat(jnp.arange(n_rows, dtype=jnp.int32), GRID_W)
    cols = jnp.tile(jnp.arange(GRID_W, dtype=jnp.int32), n_rows)
    xc = ctx
    c_act = jax.nn.silu(c)[:, None, :]
    cc_act = jax.nn.silu(c_ctx)[None, None, :]
    n_parts = len(IN_SIZES)
    for i in range(DEPTH):
        need_ctx = i < DEPTH - 1
        sh1, sc1, g1, sh2, sc2, g2 = jnp.split(c_act @ w_ada[i] + b_ada[i], N_MOD, axis=-1)
        csh1, csc1, cg1, csh2, csc2, cg2 = jnp.split(cc_act @ w_ada[i] + b_ada[i], N_MOD, axis=-1)

        h = modulate(x, norm1_g[i], sh1, sc1)
        p = split_in(h @ w_in[i])
        hc = modulate(xc, norm1_g[i], csh1, csc1)
        w_parts = split_in(w_in[i])
        needed = tuple(range(n_parts)) if need_ctx else CTX_KV_PARTS
        pc = [hc @ w_parts[j] if j in needed else None for j in range(n_parts)]

        y_a = chunk_sgu(jax.nn.gelu(p[P_SGU_U]), jax.nn.gelu(p[P_SGU_V]), sgu_w[i], sgu_b[i])
        lg_f = jax.nn.log_sigmoid(ret_decay_fwd[i].astype(jnp.float32))
        lg_b = jax.nn.log_sigmoid(ret_decay_bwd[i].astype(jnp.float32))
        y_b, yc_b = retention_mixer(p[P_RET_Q], p[P_RET_K], p[P_RET_V], p[P_RET_G],
                                    pc[P_RET_Q], pc[P_RET_K], pc[P_RET_V], pc[P_RET_G],
                                    lg_f, lg_b, rows, cols)
        lam_init = 0.8 - 0.6 * math.exp(-0.3 * i)
        lam = (jnp.exp(jnp.sum(diff_lambda_q1[i].astype(jnp.float32) * diff_lambda_k1[i].astype(jnp.float32)))
               - jnp.exp(jnp.sum(diff_lambda_q2[i].astype(jnp.float32) * diff_lambda_k2[i].astype(jnp.float32)))
               + lam_init)
        y_c, yc_c = diff_attention_mixer(p[P_DIFF_Q], p[P_DIFF_K], p[P_DIFF_V],
                                         pc[P_DIFF_Q], pc[P_DIFF_K], pc[P_DIFF_V],
                                         lam, lam_init, diff_subln_g[i], rows, cols)

        x = x + g1 * (jnp.concatenate([y_a, y_b, y_c], axis=-1) @ w_out[i])
        x = x + g2 * swiglu(modulate(x, norm2_g[i], sh2, sc2), w_gate[i], w_up[i], w_down[i])

        if need_ctx:
            yc_a = chunk_sgu(jax.nn.gelu(pc[P_SGU_U]), jax.nn.gelu(pc[P_SGU_V]), sgu_w[i], sgu_b[i])
            xc = xc + cg1 * (jnp.concatenate([yc_a, yc_b, yc_c], axis=-1) @ w_out[i])
            xc = xc + cg2 * swiglu(modulate(xc, norm2_g[i], csh2, csc2), w_gate[i], w_up[i], w_down[i])
    return rms_norm(x, final_g)
```

```cpp
#include <hip/hip_runtime.h>
#include <hip/hip_cooperative_groups.h>
#include <cstdio>
#include <cstdint>
namespace cg = cooperative_groups;

typedef unsigned short bf16_t;
typedef short bf16x8 __attribute__((ext_vector_type(8)));
typedef short s16x4 __attribute__((ext_vector_type(4)));
typedef float f32x16 __attribute__((ext_vector_type(16)));
typedef float f32x4 __attribute__((ext_vector_type(4)));
typedef float f32x2 __attribute__((ext_vector_type(2)));
typedef unsigned u32x4 __attribute__((ext_vector_type(4)));
typedef unsigned u32x2 __attribute__((ext_vector_type(2)));
#define DI __device__ __forceinline__
#define MFMA32(a, b, c) __builtin_amdgcn_mfma_f32_32x32x16_bf16((a), (b), (c), 0, 0, 0)

#ifndef DUP
#define DUP -1
#endif
constexpr int TOK = 8448, DM = 2048, DIN = 6144, DFF = 5632, NCH = 66;
constexpr float EPS = 1e-6f;
constexpr float LOG2E = 1.4426950408889634f;

constexpr size_t O_WIN = 0;
constexpr size_t O_WOUT = O_WIN + 2ull * DIN * DM * 2;
constexpr size_t O_WG = O_WOUT + 2ull * DM * DM * 2;
constexpr size_t O_WU = O_WG + 2ull * DFF * DM * 2;
constexpr size_t O_WD = O_WU + 2ull * DFF * DM * 2;
constexpr size_t O_MODS = O_WD + 2ull * DM * DFF * 2;
constexpr size_t O_TAB = O_MODS + 2ull * 2 * 12288 * 4;
constexpr size_t O_SW = O_TAB + 128ull * 32 * 8;
constexpr size_t O_SCAL = O_SW + 2ull * 4 * 16384 * 2;
constexpr size_t O_X = O_SCAL + 1024;
constexpr size_t O_H = O_X + (size_t)TOK * DM * 4;
constexpr size_t O_U = O_H + (size_t)TOK * DM * 2;
constexpr size_t SZ512 = (size_t)TOK * 512 * 2;
constexpr size_t O_VNT = O_U + SZ512;
constexpr size_t O_RQ = O_VNT + SZ512;
constexpr size_t O_RK = O_RQ + SZ512;
constexpr size_t O_RKTF = O_RK + SZ512;
constexpr size_t O_RKTB = O_RKTF + SZ512;
constexpr size_t O_RVT = O_RKTB + SZ512;
constexpr size_t O_RG = O_RVT + SZ512;
constexpr size_t O_DQ = O_RG + SZ512;
constexpr size_t O_DK = O_DQ + 2 * SZ512;
constexpr size_t O_DVT = O_DK + 2 * SZ512;
constexpr size_t O_Y = O_DVT + 2 * SZ512;
constexpr size_t O_HID = O_Y + (size_t)TOK * DM * 2;
constexpr size_t O_UT = O_HID + (size_t)TOK * DFF * 2;
constexpr size_t O_ST = O_UT + 8ull * NCH * 16384 * 4;
constexpr size_t O_PS = O_ST + 8ull * NCH * 16384 * 2;
constexpr size_t O_BAR = O_PS + 1024ull * 32768;
constexpr size_t WS_END = O_BAR + 16384;

constexpr int LROW = 144;
constexpr int TSZ = 128 * LROW;
constexpr int SMEM_BYTES = 8 * TSZ;
constexpr int CTS = 132;

struct Params {
  const float *x, *c, *ctx, *c_ctx, *w_ada, *b_ada, *norm1_g, *w_in, *sgu_w, *sgu_b, *dec_f, *dec_b;
  const float *lq1, *lk1, *lq2, *lk2, *subln, *w_out, *norm2_g, *w_gate, *w_up, *w_down, *final_g;
  float* out;
  char* ws;
};

typedef __bf16 bf16v2 __attribute__((ext_vector_type(2)));
DI unsigned short f2bf(float x) { return __builtin_bit_cast(unsigned short, (__bf16)x); }
DI unsigned pack2(float lo, float hi) { bf16v2 v = {(__bf16)lo, (__bf16)hi}; return __builtin_bit_cast(unsigned, v); }
DI float gelu_tanh(float x) { float u = 0.7978845608028654f * (x + 0.044715f * x * x * x); float e = __expf(2.f * u); return x * (1.f - __builtin_amdgcn_rcpf(e + 1.f)); }
DI float silu(float x) { return x * __builtin_amdgcn_rcpf(1.f + __expf(-x)); }
DI float ex2(float x) { return __builtin_amdgcn_exp2f(x); }
DI int tid() { int t = threadIdx.x & 255; asm volatile("" : "+v"(t)); return t; }
DI int tid512() { int t = threadIdx.x; asm volatile("" : "+v"(t)); return t; }
DI int grp() { return __builtin_amdgcn_readfirstlane((int)(threadIdx.x >> 8)); }
constexpr int GSM = 73728;

#define XB_TMO      128
#define XB_XCNT(j)  (256  + 64 * (j))
#define XB_XSUB(j)  (1280 + 64 * (j))
#define XB_XGEN(j)  (2304 + 64 * (j))
#define XB_TOP      3328
#define XB_TOPGEN   3392
#define XCD_BAR_WORDS 3456
#define XB_SPIN_CAP (1u << 18)
#define LAS __attribute__((address_space(3)))

__device__ __forceinline__ unsigned xb_ld(unsigned* p)              { return __hip_atomic_load(p, __ATOMIC_RELAXED, __HIP_MEMORY_SCOPE_AGENT); }
__device__ __forceinline__ unsigned xb_add(unsigned* p, unsigned v) { return __hip_atomic_fetch_add(p, v, __ATOMIC_RELAXED, __HIP_MEMORY_SCOPE_AGENT); }
__device__ __forceinline__ unsigned xb_xcc_id() { return (unsigned)__builtin_amdgcn_s_getreg((3 << 11) | 20) & 0xFu; }
#define XB_SPIN(cond, bar) do { unsigned _sp = 0; while (cond) { __builtin_amdgcn_s_sleep(1); \
    if ((++_sp & 255u) == 0u) { if (xb_ld(&(bar)[XB_TMO])) break; if (_sp > XB_SPIN_CAP) { atomicAdd(&(bar)[XB_TMO], 1u); break; } } } } while (0)

struct XcdBarrier {
    unsigned* bar; unsigned x;
    volatile LAS unsigned* st;
};

__device__ __forceinline__ XcdBarrier xcd_barrier_post(unsigned* bar, volatile LAS unsigned* st) {
    XcdBarrier b; b.bar = bar; b.x = xb_xcc_id(); b.st = st;
    if (threadIdx.x == 0) (void)xb_add(&bar[XB_XCNT(b.x)], 1u);
    return b;
}
__device__ __forceinline__ void xcd_barrier_complete(unsigned* bar, unsigned x, unsigned& nloc, unsigned& nx) {
    const unsigned G = gridDim.x * gridDim.y * gridDim.z;
    unsigned sum, cnt, mine, sp = 0u;
    for (;;) {
        sum = 0u; cnt = 0u; mine = 0u;
#pragma unroll
        for (unsigned j = 0; j < 16; ++j) { const unsigned c = xb_ld(&bar[XB_XCNT(j)]); sum += c; cnt += (c > 0u) ? 1u : 0u; mine = (j == x) ? c : mine; }
        if (sum == G) break;
        __builtin_amdgcn_s_sleep(1);
        if ((++sp & 255u) == 0u) { if (xb_ld(&bar[XB_TMO])) break; if (sp > XB_SPIN_CAP) { atomicAdd(&bar[XB_TMO], 1u); break; } }
    }
    nloc = mine > 0u ? mine : 1u; nx = cnt > 0u ? cnt : 1u;
}

__device__ __forceinline__ void xcd_barrier(const XcdBarrier& b) {
    asm volatile("s_waitcnt vmcnt(0)" ::: "memory");
    __syncthreads();
    if (threadIdx.x == 0) {
        unsigned* bar = b.bar;
        __builtin_amdgcn_s_waitcnt(0);
        unsigned nloc = b.st[0], nx = b.st[1];
        if (nloc == 0u) { xcd_barrier_complete(bar, b.x, nloc, nx); b.st[0] = nloc; b.st[1] = nx; }
        const unsigned old = xb_add(&bar[XB_XSUB(b.x)], 1u);
        const unsigned gen = old / nloc;
        if (old + 1u == (gen + 1u) * nloc) {
            __builtin_amdgcn_fence(__ATOMIC_RELEASE, "agent");
            asm volatile("s_waitcnt vmcnt(0)" ::: "memory");
            const unsigned og = xb_add(&bar[XB_TOP], 1u);
            const unsigned tg = og / nx;
            if (og + 1u == (tg + 1u) * nx) xb_add(&bar[XB_TOPGEN], 1u);
            else XB_SPIN(xb_ld(&bar[XB_TOPGEN]) == tg, bar);
            __builtin_amdgcn_fence(__ATOMIC_ACQUIRE, "agent");
            xb_add(&bar[XB_XGEN(b.x)], 1u);
            asm volatile("s_waitcnt vmcnt(0)" ::: "memory");
        } else {
            XB_SPIN(xb_ld(&bar[XB_XGEN(b.x)]) == gen, bar);
            __builtin_amdgcn_fence(__ATOMIC_ACQUIRE, "agent");
            asm volatile("s_waitcnt vmcnt(0)" ::: "memory");
        }
    }
    __syncthreads();
}


DI int tile_of(int i, int ntiles) {
  const int G = gridDim.x, b = blockIdx.x;
  if (G & 7) { int L = b + i * G; return L < ntiles ? L : -1; }
  const int q = (ntiles + 7) >> 3, nb = G >> 3, x = b & 7, loc = (b >> 3) + i * nb;
  if (loc >= q) return -1;
  const int L = x * q + loc;
  return L < ntiles ? L : -1;
}
DI int item_of(int i, int nitems) {
  const int j = tile_of(i, nitems >> 1);
  return j < 0 ? -1 : 2 * j + grp();
}
DI int item_of_rot(int i, int nitems) {
  const int G = gridDim.x, b = (blockIdx.x + (G >> 1)) % G, npairs = nitems >> 1;
  int j;
  if (G & 7) { j = b + i * G; if (j >= npairs) return -1; }
  else {
    const int q = (npairs + 7) >> 3, nb = G >> 3, x = b & 7, loc = (b >> 3) + i * nb;
    if (loc >= q) return -1;
    j = x * q + loc;
    if (j >= npairs) return -1;
  }
  return 2 * j + grp();
}
constexpr int GM = 4;
DI void tile_mn(int L, int nM, int nN, int& mt, int& nt) {
  const int per = GM * nN, g = L / per, fm = g * GM;
  const int gsz = (nM - fm) < GM ? (nM - fm) : GM;
  const int rem = L - g * per;
  mt = fm + rem % gsz; nt = rem / gsz;
}

DI void setup_ptrs(const bf16_t* (&ptr)[4], const bf16_t* base, size_t ld, int row0) {
  const int t = tid();
#pragma unroll
  for (int i = 0; i < 4; ++i) ptr[i] = base + (size_t)(row0 + (t >> 3) + 32 * i) * ld + (t & 7) * 8;
}

DI void gemm_main(const bf16_t* (&ap)[4], const bf16_t* (&bp)[4], int nk, char* smem, f32x16 (&acc)[2][2]) {
  const int t = tid(), lane = t & 63, w = t >> 6, wm = w >> 1, wn = w & 1, r = lane & 31, h = lane >> 5;
  const int soff = (t >> 3) * LROW + (t & 7) * 16;
  const int aoff = (64 * wm + r) * LROW + h * 16, boff = TSZ + (64 * wn + r) * LROW + h * 16;
  u32x4 ra0[4], rb0[4], ra1[4], rb1[4];
#define G_LOAD(RA, RB, KT) { _Pragma("unroll") for (int i = 0; i < 4; ++i) { RA[i] = *(const u32x4*)(ap[i] + (KT) * 64); RB[i] = *(const u32x4*)(bp[i] + (KT) * 64); } }
#define G_STORE(RA, RB, ST) { char* D_ = smem + (ST) * 2 * TSZ; _Pragma("unroll") for (int i = 0; i < 4; ++i) { *(u32x4*)(D_ + soff + i * 32 * LROW) = RA[i]; *(u32x4*)(D_ + TSZ + soff + i * 32 * LROW) = RB[i]; } }
#define G_COMPUTE(ST) { const char* S_ = smem + (ST) * 2 * TSZ; _Pragma("unroll") for (int s = 0; s < 4; ++s) { \
      const bf16x8 a0 = *(const bf16x8*)(S_ + aoff + s * 32); const bf16x8 a1 = *(const bf16x8*)(S_ + aoff + 32 * LROW + s * 32); \
      const bf16x8 b0 = *(const bf16x8*)(S_ + boff + s * 32); const bf16x8 b1 = *(const bf16x8*)(S_ + boff + 32 * LROW + s * 32); \
      acc[0][0] = MFMA32(a0, b0, acc[0][0]); acc[0][1] = MFMA32(a0, b1, acc[0][1]); acc[1][0] = MFMA32(a1, b0, acc[1][0]); acc[1][1] = MFMA32(a1, b1, acc[1][1]); } }
  G_LOAD(ra0, rb0, 0);
  G_LOAD(ra1, rb1, 1);
  __syncthreads();
  G_STORE(ra0, rb0, 0);
  __syncthreads();
  const int last = nk - 1;
  for (int kt = 0; kt < nk; kt += 2) {
    const int k2 = (kt + 2 < last) ? kt + 2 : last, k3 = (kt + 3 < last) ? kt + 3 : last;
    G_LOAD(ra0, rb0, k2);
    __builtin_amdgcn_sched_barrier(0);
    G_COMPUTE(0);
    G_STORE(ra1, rb1, 1);
    __syncthreads();
    G_LOAD(ra1, rb1, k3);
    __builtin_amdgcn_sched_barrier(0);
    G_COMPUTE(1);
    G_STORE(ra0, rb0, 0);
    __syncthreads();
  }
#undef G_LOAD
#undef G_STORE
#undef G_COMPUTE
}


constexpr int T2 = 256 * LROW;
DI void setup_ptrs256(const bf16_t* (&ptr)[4], const bf16_t* base, size_t ld, int row0) {
  const int t = tid512();
#pragma unroll
  for (int i = 0; i < 4; ++i) ptr[i] = base + (size_t)(row0 + (t >> 3) + 64 * i) * ld + (t & 7) * 8;
}
DI const bf16_t* base256(const bf16_t* base, size_t ld, int row0) { const int t = tid512(); return base + (size_t)(row0 + (t >> 3)) * ld + (t & 7) * 8; }
DI void zero_acc256(f32x16 (&acc)[4][2]) {
#pragma unroll
  for (int a = 0; a < 4; ++a)
#pragma unroll
    for (int b = 0; b < 2; ++b)
#pragma unroll
      for (int i = 0; i < 16; ++i) acc[a][b][i] = 0.f;
}
DI void gemm256(const char* a_u, unsigned a_voff, size_t astep, const char* b_u, unsigned b_voff, size_t bstep, int nk, char* smem, f32x16 (&acc)[4][2]) {
  asm volatile("" : "+s"(nk));
  const int t = tid512(), lane = t & 63, w = t >> 6, wm = w >> 2, wn = w & 3, r = lane & 31, h = lane >> 5;
  const int soff = (t >> 3) * LROW + (t & 7) * 16;
  const int aoff = (128 * wm + r) * LROW + h * 16, boff = T2 + (64 * wn + r) * LROW + h * 16;
  u32x4 ra[4], rb[4];
#pragma unroll
  for (int i = 0; i < 4; ++i) { ra[i] = *(const u32x4*)(a_u + i * astep + a_voff); rb[i] = *(const u32x4*)(b_u + i * bstep + b_voff); }
  __syncthreads();
#pragma unroll
  for (int i = 0; i < 4; ++i) { *(u32x4*)(smem + soff + i * 64 * LROW) = ra[i]; *(u32x4*)(smem + T2 + soff + i * 64 * LROW) = rb[i]; }
  const int last = nk - 1;
  {
    const int k1 = last < 1 ? last : 1;
#pragma unroll
    for (int i = 0; i < 4; ++i) { ra[i] = *(const u32x4*)(a_u + i * astep + k1 * 128 + a_voff); rb[i] = *(const u32x4*)(b_u + i * bstep + k1 * 128 + b_voff); }
  }
  __syncthreads();
  for (int kt = 0; kt < nk; ++kt) {
    const int cur = kt & 1, k2 = (kt + 2 < last) ? kt + 2 : last;
    const char* S = smem + cur * 2 * T2;
    char* D = smem + (cur ^ 1) * 2 * T2;
    const char* an = a_u + (size_t)k2 * 128;
    const char* bn = b_u + (size_t)k2 * 128;
#pragma unroll
    for (int s = 0; s < 4; ++s) {
      bf16x8 a[4], b[2];
#pragma unroll
      for (int mi = 0; mi < 4; ++mi) a[mi] = *(const bf16x8*)(S + aoff + mi * 32 * LROW + s * 32);
#pragma unroll
      for (int ni = 0; ni < 2; ++ni) b[ni] = *(const bf16x8*)(S + boff + ni * 32 * LROW + s * 32);
      *(u32x4*)(D + soff + s * 64 * LROW) = ra[s];
      *(u32x4*)(D + T2 + soff + s * 64 * LROW) = rb[s];
      ra[s] = *(const u32x4*)(an + s * astep + a_voff);
      rb[s] = *(const u32x4*)(bn + s * bstep + b_voff);
#pragma unroll
      for (int mi = 0; mi < 4; ++mi)
#pragma unroll
        for (int ni = 0; ni < 2; ++ni) acc[mi][ni] = MFMA32(a[mi], b[ni], acc[mi][ni]);
    }
    __syncthreads();
  }
}
DI unsigned voff256(size_t ld) { const int t = tid512(); return (unsigned)(((size_t)(t >> 3) * ld + (t & 7) * 8) * 2); }

DI void zero_acc(f32x16 (&acc)[2][2]) {
#pragma unroll
  for (int a = 0; a < 2; ++a)
#pragma unroll
    for (int b = 0; b < 2; ++b)
#pragma unroll
      for (int i = 0; i < 16; ++i) acc[a][b][i] = 0.f;
}

template <bool TR> DI void dump_ct(const f32x16 (&acc)[2][2], float* Ct) {
  const int t = tid(), lane = t & 63, w = t >> 6, wm = w >> 1, wn = w & 1, r = lane & 31, h = lane >> 5;
#pragma unroll
  for (int mi = 0; mi < 2; ++mi)
#pragma unroll
    for (int ni = 0; ni < 2; ++ni) {
      const int col = 64 * wn + 32 * ni + r;
      if (TR) {
#pragma unroll
        for (int g = 0; g < 4; ++g) {
          const int row = 64 * wm + 32 * mi + 8 * g + 4 * h;
          f32x4 v = {acc[mi][ni][4 * g], acc[mi][ni][4 * g + 1], acc[mi][ni][4 * g + 2], acc[mi][ni][4 * g + 3]};
          *(f32x4*)(Ct + col * CTS + row) = v;
        }
      } else {
#pragma unroll
        for (int reg = 0; reg < 16; ++reg) {
          const int row = 64 * wm + 32 * mi + (reg & 3) + 8 * (reg >> 2) + 4 * h;
          Ct[row * CTS + col] = acc[mi][ni][reg];
        }
      }
    }
}

DI void store8(bf16_t* dst, const float (&v)[8]) {
  u32x4 o; o.x = pack2(v[0], v[1]); o.y = pack2(v[2], v[3]); o.z = pack2(v[4], v[5]); o.w = pack2(v[6], v[7]);
  *(u32x4*)dst = o;
}

DI void transpose_tile(const float* src, bf16_t* dst, int K, int N, int kt, int nt, char* smem) {
  float* T = (float*)smem;
  const int t = tid();
  f32x4 v[8];
#pragma unroll
  for (int i = 0; i < 8; ++i) v[i] = __builtin_nontemporal_load((const f32x4*)(src + (size_t)(kt * 64 + (t >> 5) + 8 * i) * N + nt * 128 + (t & 31) * 4));
  __syncthreads();
#pragma unroll
  for (int i = 0; i < 8; ++i) *(f32x4*)(T + ((t >> 5) + 8 * i) * 132 + (t & 31) * 4) = v[i];
  __syncthreads();
  const int n = t >> 1, kq = (t & 1) * 32;
  bf16_t* d = dst + (size_t)(nt * 128 + n) * K + kt * 64 + kq;
#pragma unroll
  for (int j = 0; j < 4; ++j) {
    float w[8];
#pragma unroll
    for (int e = 0; e < 8; ++e) w[e] = T[(kq + 8 * j + e) * 132 + n];
    store8(d + 8 * j, w);
  }
}

DI void adaln_item(const Params& p, int it, char* smem) {
  const int l = it / 192, n0 = (it % 192) * 64;
  float* sc = (float*)smem;
  float* sx = sc + 2048;
  float* red = sx + 2048;
  const int t = tid();
  __syncthreads();
  for (int k = t; k < 2048; k += 256) { sc[k] = silu(p.c[k]); sx[k] = silu(p.c_ctx[k]); }
  __syncthreads();
  const int col = t & 63, kq = t >> 6;
  const float* wp = p.w_ada + (size_t)l * 2048 * 12288 + (size_t)(kq * 512) * 12288 + n0 + col;
  float a0 = 0.f, a1 = 0.f;
  for (int k = 0; k < 512; k += 32) {
    float wv[32];
#pragma unroll
    for (int e = 0; e < 32; ++e) wv[e] = __builtin_nontemporal_load(wp + (size_t)(k + e) * 12288);
#pragma unroll
    for (int e = 0; e < 32; ++e) { a0 += sc[kq * 512 + k + e] * wv[e]; a1 += sx[kq * 512 + k + e] * wv[e]; }
  }
  red[(kq * 64 + col) * 2] = a0; red[(kq * 64 + col) * 2 + 1] = a1;
  __syncthreads();
  if (t < 128) {
    const int cc = t & 63, s = t >> 6;
    float sum = 0.f;
#pragma unroll
    for (int q = 0; q < 4; ++q) sum += red[(q * 64 + cc) * 2 + s];
    float* mods = (float*)(p.ws + O_MODS);
    mods[(size_t)(l * 2 + s) * 12288 + n0 + cc] = sum + p.b_ada[l * 12288 + n0 + cc];
  }
}

DI void misc_item(const Params& p) {
  const int t = tid();
  f32x2* TAB = (f32x2*)(p.ws + O_TAB);
  for (int e = t; e < 4096; e += 256) {
    const int pos = e >> 5, j = e & 31;
    const float fr = powf(10000.f, -(float)j / 32.f);
    const float ang = (float)pos * fr;
    const double a = (double)ang;
    const double kk = rint(a * 0.15915494309189535);
    const float red = (float)(a - kk * 6.283185307179586);
    f32x2 cs; cs.x = __cosf(red); cs.y = __sinf(red);
    TAB[j * 128 + pos] = cs;
  }
  float* scal = (float*)(p.ws + O_SCAL);
  if (t < 16) {
    const int l = t >> 3, dir = (t >> 2) & 1, hd = t & 3;
    const float xx = (dir ? p.dec_b : p.dec_f)[l * 4 + hd];
    scal[t] = -log1pf(expf(-xx));
  }
  if (t == 16 || t == 17) {
    const int l = t - 16;
    float d1 = 0.f, d2 = 0.f;
    for (int k = 0; k < 64; ++k) { d1 += p.lq1[l * 64 + k] * p.lk1[l * 64 + k]; d2 += p.lq2[l * 64 + k] * p.lk2[l * 64 + k]; }
    const float lam_init = 0.8f - 0.6f * expf(-0.3f * (float)l);
    scal[16 + l] = expf(d1) - expf(d2) + lam_init;
    scal[18 + l] = lam_init;
  }
}

DI void transpose_item(const Params& p, int idx, char* smem) {
  const int l = idx / 6272; int r = idx % 6272;
  if (r < 1536) transpose_tile(p.w_in + (size_t)l * DM * DIN, (bf16_t*)(p.ws + O_WIN) + (size_t)l * DIN * DM, DM, DIN, r / 48, r % 48, smem);
  else if (r < 2048) { r -= 1536; transpose_tile(p.w_out + (size_t)l * DM * DM, (bf16_t*)(p.ws + O_WOUT) + (size_t)l * DM * DM, DM, DM, r / 16, r % 16, smem); }
  else if (r < 3456) { r -= 2048; transpose_tile(p.w_gate + (size_t)l * DM * DFF, (bf16_t*)(p.ws + O_WG) + (size_t)l * DFF * DM, DM, DFF, r / 44, r % 44, smem); }
  else if (r < 4864) { r -= 3456; transpose_tile(p.w_up + (size_t)l * DM * DFF, (bf16_t*)(p.ws + O_WU) + (size_t)l * DFF * DM, DM, DFF, r / 44, r % 44, smem); }
  else { r -= 4864; transpose_tile(p.w_down + (size_t)l * DFF * DM, (bf16_t*)(p.ws + O_WD) + (size_t)l * DM * DFF, DFF, DM, r / 16, r % 16, smem); }
}
DI void transpose_range(const Params& p, int first, int nitems, int my, int nblk, char* smem) {
  for (int j = my; j < (nitems >> 1); j += nblk) transpose_item(p, first + 2 * j + grp(), smem);
}
DI void idle_transposes(const Params& p, int busy_pairs, int first, int nitems, char* smem) {
  const int G = gridDim.x, b = blockIdx.x;
  int my, n_idle;
  if (G & 7) { n_idle = G - busy_pairs; my = b - busy_pairs; }
  else { const int q = (busy_pairs + 7) >> 3, nb = G >> 3; n_idle = (nb - q) * 8; my = ((b >> 3) - q) * 8 + (b & 7); if ((b >> 3) < q) my = -1; }
  if (n_idle <= 0) { n_idle = G; my = b; }
  if (my < 0) return;
  transpose_range(p, first, nitems, my, n_idle, smem);
}

DI void phase0(const Params& p, char* smem) {
  const int NT = 384 + 32 + 2 + 2048;
  for (int j = blockIdx.x; j < NT / 2; j += gridDim.x) {
    const int it = 2 * j + grp();
    if (it < 384) { adaln_item(p, it, smem); continue; }
    if (it < 416) {
      const int base = (it - 384) * 4096;
      bf16_t* SW = (bf16_t*)(p.ws + O_SW);
      for (int e = tid(); e < 4096; e += 256) SW[base + e] = f2bf(p.sgu_w[base + e]);
      continue;
    }
    if (it == 416) { misc_item(p); continue; }
    if (it == 417) continue;
    transpose_item(p, it - 418, smem);
  }
}

DI void norm_phase(const Params& p, int layer, int which) {
  const int lane = threadIdx.x & 63;
  const int wg = blockIdx.x * 8 + (threadIdx.x >> 6), nw = gridDim.x * 8;
  const float* mods = (const float*)(p.ws + O_MODS);
  const float* X = (const float*)(p.ws + O_X);
  bf16_t* H = (bf16_t*)(p.ws + O_H);
  const int row0 = (which == 2 || (layer == 1 && which == 1)) ? 256 : 0;
  for (int row = row0 + wg; row < TOK; row += nw) {
    const float* src;
    if (which == 0 && layer == 0) src = (row < 256) ? (p.ctx + (size_t)row * DM) : (p.x + (size_t)(row - 256) * DM);
    else src = X + (size_t)row * DM;
    f32x4 v[8];
    float ss = 0.f;
#pragma unroll
    for (int i = 0; i < 8; ++i) { v[i] = *(const f32x4*)(src + (lane + 64 * i) * 4); ss += v[i].x * v[i].x + v[i].y * v[i].y + v[i].z * v[i].z + v[i].w * v[i].w; }
    if (which == 0 && layer == 0 && row < 256) {
#pragma unroll
      for (int i = 0; i < 8; ++i) *(f32x4*)((float*)(p.ws + O_X) + (size_t)row * DM + (lane + 64 * i) * 4) = v[i];
    }
#pragma unroll
    for (int o = 32; o >= 1; o >>= 1) ss += __shfl_xor(ss, o);
    const float rstd = rsqrtf(ss * (1.f / DM) + EPS);
    if (which == 2) {
#pragma unroll
      for (int i = 0; i < 8; ++i) {
        const int col = (lane + 64 * i) * 4;
        const f32x4 g = *(const f32x4*)(p.final_g + col);
        f32x4 o = {v[i].x * rstd * g.x, v[i].y * rstd * g.y, v[i].z * rstd * g.z, v[i].w * rstd * g.w};
        __builtin_nontemporal_store(o, (f32x4*)(p.out + (size_t)(row - 256) * DM + col));
      }
    } else {
      const float* gw = (which == 0 ? p.norm1_g : p.norm2_g) + layer * DM;
      const float* mb = mods + (size_t)(layer * 2 + (row < 256 ? 1 : 0)) * 12288 + (which == 0 ? 0 : 3 * DM);
#pragma unroll
      for (int i = 0; i < 8; ++i) {
        const int col = (lane + 64 * i) * 4;
        const f32x4 g = *(const f32x4*)(gw + col);
        const f32x4 sh = *(const f32x4*)(mb + col);
        const f32x4 sc = *(const f32x4*)(mb + DM + col);
        const float o0 = v[i].x * rstd * g.x * (1.f + sc.x) + sh.x, o1 = v[i].y * rstd * g.y * (1.f + sc.y) + sh.y;
        const float o2 = v[i].z * rstd * g.z * (1.f + sc.z) + sh.z, o3 = v[i].w * rstd * g.w * (1.f + sc.w) + sh.w;
        u32x2 o; o.x = pack2(o0, o1); o.y = pack2(o2, o3);
        *(u32x2*)(H + (size_t)row * DM + col) = o;
      }
    }
  }
}

DI void inproj_epi(const Params& p, int layer, int mt, int nt, const float* Ct, int cts = CTS) {
  const int t = tid(), lane = t & 63, w = t >> 6, rr = lane & 31, half = lane >> 5;
  const int lrow = 32 * w + rr, tok = mt * 128 + lrow;
  const bool is_ctx = mt < 2;
  const int tl = tok - 256, prow = (tl >> 6) & 127, pcol = tl & 63;
  const f32x2* TAB = (const f32x2*)(p.ws + O_TAB);
  const float* scal = (const float*)(p.ws + O_SCAL);
  float v[8][8];
#pragma unroll
  for (int i = 0; i < 8; ++i) {
    const f32x4 a = *(const f32x4*)(Ct + lrow * cts + 8 * (half + 2 * i));
    const f32x4 b = *(const f32x4*)(Ct + lrow * cts + 8 * (half + 2 * i) + 4);
    v[i][0] = a.x; v[i][1] = a.y; v[i][2] = a.z; v[i][3] = a.w; v[i][4] = b.x; v[i][5] = b.y; v[i][6] = b.z; v[i][7] = b.w;
  }
  if (nt < 4) {
    bf16_t* U = (bf16_t*)(p.ws + O_U) + (size_t)tok * 512 + nt * 128;
#pragma unroll
    for (int i = 0; i < 8; ++i) {
#pragma unroll
      for (int e = 0; e < 8; ++e) v[i][e] = gelu_tanh(v[i][e]);
      store8(U + 8 * (half + 2 * i), v[i]);
    }
  } else if (nt < 8) {
    const int g = nt - 4;
    float ss = 0.f;
#pragma unroll
    for (int i = 0; i < 8; ++i)
#pragma unroll
      for (int e = 0; e < 8; ++e) { v[i][e] = gelu_tanh(v[i][e]); ss += v[i][e] * v[i][e]; }
    ss += __shfl_xor(ss, 32);
    const float rstd = rsqrtf(ss * (1.f / 128.f) + EPS);
    bf16_t* VNT = (bf16_t*)(p.ws + O_VNT) + (size_t)(g * NCH + mt) * 16384 + lrow;
#pragma unroll
    for (int i = 0; i < 8; ++i)
#pragma unroll
      for (int e = 0; e < 8; ++e) VNT[(8 * (half + 2 * i) + e) * 128] = f2bf(v[i][e] * rstd);
  } else if (nt < 16) {
    const int isk = nt >= 12, hd = (nt - 8) & 3;
    if (!is_ctx) {
#pragma unroll
      for (int ii = 0; ii < 4; ++ii) {
        const int i = (ii & 1) + 4 * (ii >> 1);
        const int pos = (i < 4) ? prow : pcol;
#pragma unroll
        for (int e = 0; e < 8; ++e) {
          const int c = 8 * (half + 2 * i) + e;
          const f32x2 cs = TAB[(c & 31) * 128 + pos];
          const float x1 = v[i][e], x2 = v[i + 2][e];
          v[i][e] = x1 * cs.x - x2 * cs.y; v[i + 2][e] = x1 * cs.y + x2 * cs.x;
        }
      }
    }
    if (!isk) {
      bf16_t* RQ = (bf16_t*)(p.ws + O_RQ) + (size_t)tok * 512 + hd * 128;
#pragma unroll
      for (int i = 0; i < 8; ++i) store8(RQ + 8 * (half + 2 * i), v[i]);
    } else {
      const float scale = 0.08838834764831845f;
      const float lgf = scal[layer * 8 + hd], lgb = scal[layer * 8 + 4 + hd];
      const float df = ex2((float)(127 - lrow) * lgf * LOG2E), db = ex2((float)lrow * lgb * LOG2E);
      bf16_t* RK = (bf16_t*)(p.ws + O_RK) + (size_t)tok * 512 + hd * 128;
      bf16_t* KF = (bf16_t*)(p.ws + O_RKTF) + (size_t)(hd * 128) * TOK + tok;
      bf16_t* KB = (bf16_t*)(p.ws + O_RKTB) + (size_t)(hd * 128) * TOK + tok;
#pragma unroll
      for (int i = 0; i < 8; ++i) {
#pragma unroll
        for (int e = 0; e < 8; ++e) {
          v[i][e] *= scale;
          const int c = 8 * (half + 2 * i) + e;
          KF[(size_t)c * TOK] = f2bf(v[i][e] * df);
          KB[(size_t)c * TOK] = f2bf(v[i][e] * db);
        }
        store8(RK + 8 * (half + 2 * i), v[i]);
      }
    }
  } else if (nt < 20) {
    const int hd = nt - 16;
    bf16_t* VT = (bf16_t*)(p.ws + O_RVT) + (size_t)(hd * 128) * TOK + tok;
#pragma unroll
    for (int i = 0; i < 8; ++i)
#pragma unroll
      for (int e = 0; e < 8; ++e) VT[(size_t)(8 * (half + 2 * i) + e) * TOK] = f2bf(v[i][e]);
  } else if (nt < 24) {
    const int hd = nt - 20;
    bf16_t* RG = (bf16_t*)(p.ws + O_RG) + (size_t)tok * 512 + hd * 128;
#pragma unroll
    for (int i = 0; i < 8; ++i) {
#pragma unroll
      for (int e = 0; e < 8; ++e) v[i][e] = silu(v[i][e]);
      store8(RG + 8 * (half + 2 * i), v[i]);
    }
  } else if (nt < 40) {
    const int isk = nt >= 32, hd = (nt - 24) & 7;
    if (!is_ctx) {
#pragma unroll
      for (int i = 0; i < 8; i += 2) {
        const int pos = (i & 2) ? pcol : prow;
#pragma unroll
        for (int e = 0; e < 8; ++e) {
          const int c = 8 * (half + 2 * i) + e;
          const f32x2 cs = TAB[2 * (c & 15) * 128 + pos];
          const float x1 = v[i][e], x2 = v[i + 1][e];
          v[i][e] = x1 * cs.x - x2 * cs.y; v[i + 1][e] = x1 * cs.y + x2 * cs.x;
        }
      }
    }
    bf16_t* D = (bf16_t*)(p.ws + (isk ? O_DK : O_DQ)) + (size_t)tok * 1024 + hd * 128;
    const float sc = isk ? 1.f : 0.125f * LOG2E;
#pragma unroll
    for (int i = 0; i < 8; ++i) {
#pragma unroll
      for (int e = 0; e < 8; ++e) v[i][e] *= sc;
      store8(D + 8 * (half + 2 * i), v[i]);
    }
  } else {
    const int hd = nt - 40;
    bf16_t* VT = (bf16_t*)(p.ws + O_DVT) + (size_t)(hd * 128) * TOK + tok;
#pragma unroll
    for (int i = 0; i < 8; ++i)
#pragma unroll
      for (int e = 0; e < 8; ++e) VT[(size_t)(8 * (half + 2 * i) + e) * TOK] = f2bf(v[i][e]);
  }
}


template <int NI> DI void inproj_epi_reg(const Params& p, int layer, int nt, int tok, int h, f32x16 (&acc)[4][2]) {
  const int tl = tok - 256, prow = (tl >> 6) & 127, pcol = tl & 63;
  const f32x2* TAB = (const f32x2*)(p.ws + O_TAB);
  const float* scal = (const float*)(p.ws + O_SCAL);
#define ST4(BASE) { _Pragma("unroll") for (int mi = 0; mi < 4; ++mi) _Pragma("unroll") for (int g = 0; g < 4; ++g) { \
      u32x2 o_; o_.x = pack2(acc[mi][NI][4 * g], acc[mi][NI][4 * g + 1]); o_.y = pack2(acc[mi][NI][4 * g + 2], acc[mi][NI][4 * g + 3]); *(u32x2*)((BASE) + 32 * mi + 8 * g + 4 * h) = o_; } }
#define STT(BASE, MUL) { bf16_t* q_ = (BASE) + (size_t)(4 * h) * TOK; _Pragma("unroll") for (int mi = 0; mi < 4; ++mi) _Pragma("unroll") for (int g = 0; g < 4; ++g) { \
      _Pragma("unroll") for (int e = 0; e < 4; ++e) q_[(size_t)e * TOK] = f2bf(acc[mi][NI][4 * g + e] * (MUL)); q_ += (size_t)8 * TOK; asm volatile("" : "+v"(q_)); } }
  if (nt < 4) {
#pragma unroll
    for (int mi = 0; mi < 4; ++mi)
#pragma unroll
      for (int reg = 0; reg < 16; ++reg) acc[mi][NI][reg] = gelu_tanh(acc[mi][NI][reg]);
    bf16_t* U = (bf16_t*)(p.ws + O_U) + (size_t)tok * 512 + nt * 128;
    ST4(U);
  } else if (nt < 8) {
    const int g_ = nt - 4;
    float ss = 0.f;
#pragma unroll
    for (int mi = 0; mi < 4; ++mi)
#pragma unroll
      for (int reg = 0; reg < 16; ++reg) { acc[mi][NI][reg] = gelu_tanh(acc[mi][NI][reg]); ss += acc[mi][NI][reg] * acc[mi][NI][reg]; }
    ss += __shfl_xor(ss, 32);
    const float rstd = rsqrtf(ss * (1.f / 128.f) + EPS);
    bf16_t* VNT = (bf16_t*)(p.ws + O_VNT) + (size_t)(g_ * NCH + (tok >> 7)) * 16384 + (tok & 127);
#pragma unroll
    for (int mi = 0; mi < 4; ++mi)
#pragma unroll
      for (int reg = 0; reg < 16; ++reg) VNT[(32 * mi + 8 * (reg >> 2) + 4 * h + (reg & 3)) * 128] = f2bf(acc[mi][NI][reg] * rstd);
  } else if (nt < 16) {
    const int isk = nt >= 12, hd = (nt - 8) & 3;
#pragma unroll
    for (int mi = 0; mi < 4; mi += 2) {
      const int pos = (mi == 0) ? prow : pcol;
#pragma unroll
      for (int reg = 0; reg < 16; ++reg) {
        const f32x2 cs = TAB[(8 * (reg >> 2) + 4 * h + (reg & 3)) * 128 + pos];
        const float x1 = acc[mi][NI][reg], x2 = acc[mi + 1][NI][reg];
        acc[mi][NI][reg] = x1 * cs.x - x2 * cs.y; acc[mi + 1][NI][reg] = x1 * cs.y + x2 * cs.x;
      }
    }
    if (!isk) {
      bf16_t* RQ = (bf16_t*)(p.ws + O_RQ) + (size_t)tok * 512 + hd * 128;
      ST4(RQ);
    } else {
      const float scale = 0.08838834764831845f;
      const float lgf = scal[layer * 8 + hd], lgb = scal[layer * 8 + 4 + hd];
      const int j = tok & 127;
      const float df = ex2((float)(127 - j) * lgf * LOG2E), db = ex2((float)j * lgb * LOG2E);
#pragma unroll
      for (int mi = 0; mi < 4; ++mi)
#pragma unroll
        for (int reg = 0; reg < 16; ++reg) acc[mi][NI][reg] *= scale;
      bf16_t* RK = (bf16_t*)(p.ws + O_RK) + (size_t)tok * 512 + hd * 128;
      ST4(RK);
      bf16_t* KF = (bf16_t*)(p.ws + O_RKTF) + (size_t)(hd * 128) * TOK + tok;
      bf16_t* KB = (bf16_t*)(p.ws + O_RKTB) + (size_t)(hd * 128) * TOK + tok;
      STT(KF, df);
      STT(KB, db);
    }
  } else if (nt < 20) {
    bf16_t* VT = (bf16_t*)(p.ws + O_RVT) + (size_t)((nt - 16) * 128) * TOK + tok;
    STT(VT, 1.f);
  } else if (nt < 24) {
#pragma unroll
    for (int mi = 0; mi < 4; ++mi)
#pragma unroll
      for (int reg = 0; reg < 16; ++reg) acc[mi][NI][reg] = silu(acc[mi][NI][reg]);
    bf16_t* RG = (bf16_t*)(p.ws + O_RG) + (size_t)tok * 512 + (nt - 20) * 128;
    ST4(RG);
  } else if (nt < 40) {
    const int isk = nt >= 32, hd = (nt - 24) & 7;
    const float sc = isk ? 1.f : 0.125f * LOG2E;
#pragma unroll
    for (int mi = 0; mi < 4; ++mi) {
      const int pos = (mi & 1) ? pcol : prow;
#pragma unroll
      for (int reg = 0; reg < 8; ++reg) {
        const f32x2 cs = TAB[2 * (8 * (reg >> 2) + 4 * h + (reg & 3)) * 128 + pos];
        const float x1 = acc[mi][NI][reg], x2 = acc[mi][NI][reg + 8];
        acc[mi][NI][reg] = (x1 * cs.x - x2 * cs.y) * sc; acc[mi][NI][reg + 8] = (x1 * cs.y + x2 * cs.x) * sc;
      }
    }
    bf16_t* D = (bf16_t*)(p.ws + (isk ? O_DK : O_DQ)) + (size_t)tok * 1024 + hd * 128;
    ST4(D);
  } else {
    bf16_t* VT = (bf16_t*)(p.ws + O_DVT) + (size_t)((nt - 40) * 128) * TOK + tok;
    STT(VT, 1.f);
  }
#undef ST4
#undef STT
}

DI void inproj_phase(const Params& p, int layer, char* smem) {
  const bf16_t* H = (const bf16_t*)(p.ws + O_H);
  const bf16_t* W = (const bf16_t*)(p.ws + O_WIN) + (size_t)layer * DIN * DM;
  for (int i = 0;; ++i) {
    const int L = tile_of(i, 32 * 24);
    if (L < 0) break;
    int tm, tn; tile_mn(L, 32, 24, tm, tn);
    f32x16 acc[4][2]; zero_acc256(acc);
    gemm256((const char*)(W + (size_t)(tn * 256) * DM), voff256(DM), (size_t)128 * DM, (const char*)(H + (size_t)(256 + tm * 256) * DM), voff256(DM), (size_t)128 * DM, DM / 64, smem, acc);
    const int t = tid512(), lane = t & 63, w = t >> 6, wm = w >> 2, wn = w & 3, r = lane & 31, h = lane >> 5;
    inproj_epi_reg<0>(p, layer, 2 * tn + wm, 256 + 256 * tm + 64 * wn + r, h, acc);
    inproj_epi_reg<1>(p, layer, 2 * tn + wm, 256 + 256 * tm + 64 * wn + 32 + r, h, acc);
  }
  char* sg = smem + grp() * GSM;
  const int nctx = (layer == 1) ? 48 : 96;
  for (int i = 0;; ++i) {
    const int L = item_of(i, nctx);
    if (L < 0) break;
    const int mt = L & 1, ix = L >> 1;
    const int nt = (layer == 1) ? (ix < 8 ? 12 + ix : 24 + ix) : ix;
    const bf16_t *ap[4], *bp[4];
    setup_ptrs(ap, H, DM, mt * 128); setup_ptrs(bp, W, DM, nt * 128);
    f32x16 acc[2][2]; zero_acc(acc);
    gemm_main(ap, bp, DM / 64, sg, acc);
    dump_ct<false>(acc, (float*)sg);
    __syncthreads();
    inproj_epi(p, layer, mt, nt, (const float*)sg);
  }
  if (layer == 0) idle_transposes(p, nctx >> 1, 2048, 4224, sg);
  else idle_transposes(p, nctx >> 1, 6272 + 4480, 1792, sg);
}

DI void attn_item(const Params& p, int layer, int hd, int q0, int nkeys, char* smem) {
  constexpr int KT = 64 * 272, ST = KT + 128 * 136;
  const int t = tid(), lane = t & 63, w = t >> 6, r = lane & 31, h = lane >> 5;
  const bf16_t* DQ = (const bf16_t*)(p.ws + O_DQ);
  const bf16_t* DK = (const bf16_t*)(p.ws + O_DK);
  const bf16_t* DVT = (const bf16_t*)(p.ws + O_DVT);
  const float* scal = (const float*)(p.ws + O_SCAL);
  const int q = q0 + 32 * w + r;
  bf16x8 qf[2][4];
#pragma unroll
  for (int mp = 0; mp < 2; ++mp)
#pragma unroll
    for (int s = 0; s < 4; ++s) qf[mp][s] = *(const bf16x8*)(DQ + (size_t)q * 1024 + hd * 128 + 64 * mp + 16 * s + 8 * h);
  const int nkb = nkeys >> 6;
  const bf16_t* kp = DK + (size_t)(t >> 4) * 1024 + hd * 128 + (t & 15) * 8;
  const int ksoff = (t >> 4) * 272 + (t & 15) * 16;
  const bf16_t* vp = DVT + (size_t)(hd * 128 + (t >> 3)) * TOK + (t & 7) * 8;
  const int vsoff = KT + (t >> 3) * 136 + (t & 7) * 16;
  u32x4 rk[4], rv[4];

  float m1 = -1e30f, l1 = 0.f, m2 = -1e30f, l2 = 0.f;
#pragma unroll
  for (int i = 0; i < 4; ++i) rk[i] = *(const u32x4*)(kp + (size_t)(16 * i) * 1024);
  __syncthreads();
#pragma unroll
  for (int i = 0; i < 4; ++i) *(u32x4*)(smem + ksoff + i * 16 * 272) = rk[i];
  __syncthreads();
  for (int kb = 0; kb < nkb; ++kb) {
    const int cur = kb & 1;
    const bool more = (kb + 1) < nkb;
    if (more) {
#pragma unroll
      for (int i = 0; i < 4; ++i) rk[i] = *(const u32x4*)(kp + (size_t)((kb + 1) * 64 + 16 * i) * 1024);
    }
    const char* Ks = smem + cur * ST;
#pragma unroll
    for (int kt = 0; kt < 2; ++kt) {
      f32x16 s1, s2;
#pragma unroll
      for (int i = 0; i < 16; ++i) { s1[i] = 0.f; s2[i] = 0.f; }
#pragma unroll
      for (int s = 0; s < 4; ++s) {
        const bf16x8 a1 = *(const bf16x8*)(Ks + (32 * kt + r) * 272 + 32 * s + 16 * h);
        const bf16x8 a2 = *(const bf16x8*)(Ks + (32 * kt + r) * 272 + 128 + 32 * s + 16 * h);
        s1 = MFMA32(a1, qf[0][s], s1);
        s2 = MFMA32(a2, qf[1][s], s2);
      }
      {
        float mx = s1[0];
#pragma unroll
        for (int i = 1; i < 16; ++i) mx = fmaxf(mx, s1[i]);
        const float mn = fmaxf(m1, mx * LOG2E);
        float sum = 0.f;
#pragma unroll
        for (int i = 0; i < 16; ++i) sum += ex2(s1[i] * LOG2E - mn);
        l1 = l1 * ex2(m1 - mn) + sum; m1 = mn;
      }
      {
        float mx = s2[0];
#pragma unroll
        for (int i = 1; i < 16; ++i) mx = fmaxf(mx, s2[i]);
        const float mn = fmaxf(m2, mx * LOG2E);
        float sum = 0.f;
#pragma unroll
        for (int i = 0; i < 16; ++i) sum += ex2(s2[i] * LOG2E - mn);
        l2 = l2 * ex2(m2 - mn) + sum; m2 = mn;
      }
    }
    if (more) {
      char* D = smem + (cur ^ 1) * ST;
#pragma unroll
      for (int i = 0; i < 4; ++i) *(u32x4*)(D + ksoff + i * 16 * 272) = rk[i];
    }
    __syncthreads();
  }
  float inv1, inv2;
  {
    const float mo = __shfl_xor(m1, 32), lo = __shfl_xor(l1, 32);
    const float M = fmaxf(m1, mo);
    const float Ls = l1 * ex2(m1 - M) + lo * ex2(mo - M);
    m1 = M; inv1 = 1.f / Ls;
  }
  {
    const float mo = __shfl_xor(m2, 32), lo = __shfl_xor(l2, 32);
    const float M = fmaxf(m2, mo);
    const float Ls = l2 * ex2(m2 - M) + lo * ex2(mo - M);
    m2 = M; inv2 = scal[16 + layer] / Ls;
  }

  f32x16 o[4];
#pragma unroll
  for (int vt = 0; vt < 4; ++vt)
#pragma unroll
    for (int i = 0; i < 16; ++i) o[vt][i] = 0.f;
#pragma unroll
  for (int i = 0; i < 4; ++i) { rk[i] = *(const u32x4*)(kp + (size_t)(16 * i) * 1024); rv[i] = *(const u32x4*)(vp + (size_t)(32 * i) * TOK); }
  __syncthreads();
#pragma unroll
  for (int i = 0; i < 4; ++i) {
    *(u32x4*)(smem + ksoff + i * 16 * 272) = rk[i];
    u32x2 lo2 = {rv[i].x, rv[i].y}, hi2 = {rv[i].z, rv[i].w};
    *(u32x2*)(smem + vsoff + i * 32 * 136) = lo2; *(u32x2*)(smem + vsoff + i * 32 * 136 + 8) = hi2;
  }
  __syncthreads();
  for (int kb = 0; kb < nkb; ++kb) {
    const int cur = kb & 1;
    const bool more = (kb + 1) < nkb;
    const char* Ks = smem + cur * ST;
    const char* Vs = Ks + KT;
    char* D = smem + (cur ^ 1) * ST;
    auto step = [&](const int kt) {
      f32x16 s1, s2;
#pragma unroll
      for (int i = 0; i < 16; ++i) { s1[i] = 0.f; s2[i] = 0.f; }
#pragma unroll
      for (int s = 0; s < 4; ++s) {
        const bf16x8 a1 = *(const bf16x8*)(Ks + (32 * kt + r) * 272 + 32 * s + 16 * h);
        const bf16x8 a2 = *(const bf16x8*)(Ks + (32 * kt + r) * 272 + 128 + 32 * s + 16 * h);
        s1 = MFMA32(a1, qf[0][s], s1);
        s2 = MFMA32(a2, qf[1][s], s2);
      }
#pragma unroll
      for (int s2i = 0; s2i < 2; ++s2i) {
        float pv[8];
#pragma unroll
        for (int i = 0; i < 8; ++i) pv[i] = ex2(s1[8 * s2i + i] * LOG2E - m1) * inv1 - ex2(s2[8 * s2i + i] * LOG2E - m2) * inv2;
        u32x4 pk; pk.x = pack2(pv[0], pv[1]); pk.y = pack2(pv[2], pv[3]); pk.z = pack2(pv[4], pv[5]); pk.w = pack2(pv[6], pv[7]);
        const bf16x8 pb = __builtin_bit_cast(bf16x8, pk);
#pragma unroll
        for (int vt = 0; vt < 4; ++vt) {
          const char* vrow = Vs + (32 * vt + r) * 136 + (32 * kt + 16 * s2i + 4 * h) * 2;
          const s16x4 lo = *(const s16x4*)vrow, hi = *(const s16x4*)(vrow + 16);
          const bf16x8 a = __builtin_shufflevector(lo, hi, 0, 1, 2, 3, 4, 5, 6, 7);
          o[vt] = MFMA32(a, pb, o[vt]);
        }
      }
    };
    if (more) {
#pragma unroll
      for (int i = 0; i < 4; ++i) rk[i] = *(const u32x4*)(kp + (size_t)((kb + 1) * 64 + 16 * i) * 1024);
    }
    step(0);
    if (more) {
#pragma unroll
      for (int i = 0; i < 4; ++i) *(u32x4*)(D + ksoff + i * 16 * 272) = rk[i];
#pragma unroll
      for (int i = 0; i < 4; ++i) rk[i] = *(const u32x4*)(vp + (size_t)(32 * i) * TOK + (kb + 1) * 64);
    }
    step(1);
    if (more) {
#pragma unroll
      for (int i = 0; i < 4; ++i) {
        u32x2 lo2 = {rk[i].x, rk[i].y}, hi2 = {rk[i].z, rk[i].w};
        *(u32x2*)(D + vsoff + i * 32 * 136) = lo2; *(u32x2*)(D + vsoff + i * 32 * 136 + 8) = hi2;
      }
    }
    __syncthreads();
  }
  float ss = 0.f;
#pragma unroll
  for (int vt = 0; vt < 4; ++vt)
#pragma unroll
    for (int i = 0; i < 16; ++i) ss += o[vt][i] * o[vt][i];
  ss += __shfl_xor(ss, 32);
  const float mul = rsqrtf(ss * (1.f / 128.f) + EPS) * (1.f - scal[18 + layer]);
  bf16_t* Y = (bf16_t*)(p.ws + O_Y) + (size_t)q * DM + 1024 + hd * 128;
  const float* sg = p.subln + layer * 128;
#pragma unroll
  for (int vt = 0; vt < 4; ++vt)
#pragma unroll
    for (int g = 0; g < 4; ++g) {
      const int vv = 32 * vt + 8 * g + 4 * h;
      const f32x4 gg = *(const f32x4*)(sg + vv);
      u32x2 ov; ov.x = pack2(o[vt][4 * g] * mul * gg.x, o[vt][4 * g + 1] * mul * gg.y);
      ov.y = pack2(o[vt][4 * g + 2] * mul * gg.z, o[vt][4 * g + 3] * mul * gg.w);
      *(u32x2*)(Y + vv) = ov;
    }
}


DI void attn_block(const Params& p, int layer, int hd, int q0, int nkeys, char* smem) {
  constexpr int KT = 64 * 272, VROW = 144, ST = KT + 128 * VROW;
  const int t = tid512(), lane = t & 63, w = t >> 6, mp = w >> 2, wq = w & 3, r = lane & 31, h = lane >> 5;
  const bf16_t* DQ = (const bf16_t*)(p.ws + O_DQ);
  const bf16_t* DK = (const bf16_t*)(p.ws + O_DK);
  const bf16_t* DVT = (const bf16_t*)(p.ws + O_DVT);
  const float* scal = (const float*)(p.ws + O_SCAL);
  const int q = q0 + 32 * wq + r;
  bf16x8 qf[4];
#pragma unroll
  for (int s = 0; s < 4; ++s) qf[s] = *(const bf16x8*)(DQ + (size_t)q * 1024 + hd * 128 + 64 * mp + 16 * s + 8 * h);
  const int nkb = nkeys >> 6, lastkb = nkb - 1;
  const bf16_t* kp = DK + (size_t)(t >> 4) * 1024 + hd * 128 + (t & 15) * 8;
  const int ksoff = (t >> 4) * 272 + (t & 15) * 16;
  const bf16_t* vp = DVT + (size_t)(hd * 128 + (t >> 3)) * TOK + (t & 7) * 8;
  const int vsoff = KT + (t >> 3) * VROW + ((t & 7) >> 1) * 32 + (t & 1) * 8;
  u32x4 rk[2], rv[2];
#define A_LOAD(KB) { _Pragma("unroll") for (int i = 0; i < 2; ++i) { rk[i] = *(const u32x4*)(kp + (size_t)((KB) * 64 + 32 * i) * 1024); rv[i] = *(const u32x4*)(vp + (size_t)(64 * i) * TOK + (KB) * 64); } }
#define A_STORE(STG) { char* D_ = smem + (STG) * ST; _Pragma("unroll") for (int i = 0; i < 2; ++i) { *(u32x4*)(D_ + ksoff + i * 32 * 272) = rk[i]; \
      u32x2 lo2_ = {rv[i].x, rv[i].y}, hi2_ = {rv[i].z, rv[i].w}; *(u32x2*)(D_ + vsoff + i * 64 * VROW) = lo2_; *(u32x2*)(D_ + vsoff + i * 64 * VROW + 16) = hi2_; } }
#define A_SCORES(DST, STG) { const char* Ks_ = smem + (STG) * ST; _Pragma("unroll") for (int kt = 0; kt < 2; ++kt) { \
      _Pragma("unroll") for (int i = 0; i < 16; ++i) DST[kt][i] = 0.f; \
      _Pragma("unroll") for (int s = 0; s < 4; ++s) { const bf16x8 a_ = *(const bf16x8*)(Ks_ + (32 * kt + r) * 272 + 128 * mp + 32 * s + 16 * h); DST[kt] = MFMA32(a_, qf[s], DST[kt]); } } }
  A_LOAD(0);
  __syncthreads();
  A_STORE(0);
  A_LOAD(lastkb < 1 ? lastkb : 1);
  A_STORE(1);
  A_LOAD(lastkb < 2 ? lastkb : 2);
  __syncthreads();
  float m = -1e30f, l = 0.f;
  f32x16 o[4];
#pragma unroll
  for (int vt = 0; vt < 4; ++vt)
#pragma unroll
    for (int i = 0; i < 16; ++i) o[vt][i] = 0.f;
  f32x16 sc[2], sn[2];
  A_SCORES(sc, 0);
  int c0 = 0, c1 = 1, c2 = 2;
  for (int kb = 0; kb < nkb; ++kb) {
    const char* Vs = smem + c0 * ST + KT;
    A_STORE(c2);
    A_LOAD((kb + 3 < lastkb) ? kb + 3 : lastkb);
    if (kb + 1 < nkb) A_SCORES(sn, c1);
    float mx = fmaxf(sc[0][0], sc[1][0]);
#pragma unroll
    for (int i = 1; i < 16; ++i) mx = fmaxf(mx, fmaxf(sc[0][i], sc[1][i]));
    {
      const auto pr_ = __builtin_amdgcn_permlane32_swap(__float_as_uint(mx), __float_as_uint(mx), false, false);
      mx = fmaxf(__uint_as_float(pr_[0]), __uint_as_float(pr_[1]));
    }
    if (__any(mx > m + 8.f)) {
      const float mn = (mx > m + 8.f) ? mx : m;
      const float alpha = ex2(m - mn);
      l *= alpha;
#pragma unroll
      for (int vt = 0; vt < 4; ++vt)
#pragma unroll
        for (int i = 0; i < 16; ++i) o[vt][i] *= alpha;
      m = mn;
    }
    bf16x8 va[2][4];
    const char* vbase = Vs + r * VROW + 16 * h;
#pragma unroll
    for (int vt = 0; vt < 4; ++vt) va[0][vt] = *(const bf16x8*)(vbase + 32 * vt * VROW);
    float ls[4] = {0.f, 0.f, 0.f, 0.f};
#pragma unroll
    for (int st = 0; st < 4; ++st) {
      if (st < 3) {
#pragma unroll
        for (int vt = 0; vt < 4; ++vt) va[(st + 1) & 1][vt] = *(const bf16x8*)(vbase + 32 * vt * VROW + (st + 1) * 32);
      }
      float pv[8];
#pragma unroll
      for (int i = 0; i < 8; ++i) { pv[i] = ex2(sc[st >> 1][8 * (st & 1) + i] - m); ls[i & 3] += pv[i]; }
      u32x4 pk; pk.x = pack2(pv[0], pv[1]); pk.y = pack2(pv[2], pv[3]); pk.z = pack2(pv[4], pv[5]); pk.w = pack2(pv[6], pv[7]);
      const bf16x8 pb = __builtin_bit_cast(bf16x8, pk);
#pragma unroll
      for (int vt = 0; vt < 4; ++vt) o[vt] = MFMA32(va[st & 1][vt], pb, o[vt]);
    }
    l += (ls[0] + ls[1]) + (ls[2] + ls[3]);
    __syncthreads();
    sc[0] = sn[0]; sc[1] = sn[1];
    { const int tmp = c0; c0 = c1; c1 = c2; c2 = tmp; }
  }
#undef A_SCORES
#undef A_LOAD
#undef A_STORE
  l += __shfl_xor(l, 32);
  const float scl = (mp == 0 ? 1.f : scal[16 + layer]) / l;
  float* Xc = (float*)smem;
  const int xrow = (32 * wq + r) * CTS;
  if (mp == 1) {
#pragma unroll
    for (int vt = 0; vt < 4; ++vt)
#pragma unroll
      for (int g = 0; g < 4; ++g) {
        f32x4 v4 = {o[vt][4 * g] * scl, o[vt][4 * g + 1] * scl, o[vt][4 * g + 2] * scl, o[vt][4 * g + 3] * scl};
        *(f32x4*)(Xc + xrow + 32 * vt + 8 * g + 4 * h) = v4;
      }
  }
  __syncthreads();
  if (mp == 0) {
    float ss = 0.f;
#pragma unroll
    for (int vt = 0; vt < 4; ++vt)
#pragma unroll
      for (int g = 0; g < 4; ++g) {
        const f32x4 x4 = *(const f32x4*)(Xc + xrow + 32 * vt + 8 * g + 4 * h);
        o[vt][4 * g] = o[vt][4 * g] * scl - x4.x; o[vt][4 * g + 1] = o[vt][4 * g + 1] * scl - x4.y;
        o[vt][4 * g + 2] = o[vt][4 * g + 2] * scl - x4.z; o[vt][4 * g + 3] = o[vt][4 * g + 3] * scl - x4.w;
        ss += o[vt][4 * g] * o[vt][4 * g] + o[vt][4 * g + 1] * o[vt][4 * g + 1] + o[vt][4 * g + 2] * o[vt][4 * g + 2] + o[vt][4 * g + 3] * o[vt][4 * g + 3];
      }
    ss += __shfl_xor(ss, 32);
    const float mul = rsqrtf(ss * (1.f / 128.f) + EPS) * (1.f - scal[18 + layer]);
    bf16_t* Y = (bf16_t*)(p.ws + O_Y) + (size_t)q * DM + 1024 + hd * 128;
    const float* sg = p.subln + layer * 128;
#pragma unroll
    for (int vt = 0; vt < 4; ++vt)
#pragma unroll
      for (int g = 0; g < 4; ++g) {
        const int vv = 32 * vt + 8 * g + 4 * h;
        const f32x4 gg = *(const f32x4*)(sg + vv);
        u32x2 ov; ov.x = pack2(o[vt][4 * g] * mul * gg.x, o[vt][4 * g + 1] * mul * gg.y);
        ov.y = pack2(o[vt][4 * g + 2] * mul * gg.z, o[vt][4 * g + 3] * mul * gg.w);
        *(u32x2*)(Y + vv) = ov;
      }
  }
  __syncthreads();
}

DI void mix_phase(const Params& p, int layer, char* smem_blk, char* smem) {
  for (int i = 0;; ++i) {
    const int it = tile_of(i, 512);
    if (it < 0) break;
    attn_block(p, layer, it >> 6, 256 + 128 * (it & 63), TOK, smem_blk);
  }
  if (layer == 0) {
    for (int i = 0;; ++i) {
      const int it = tile_of(i, 16);
      if (it < 0) break;
      attn_block(p, layer, it >> 1, 128 * (it & 1), 256, smem_blk);
    }
  }
  const int c0 = layer == 0 ? 0 : 2;
  const int nS = (NCH - c0) * 4, nR = NCH * 8;
  for (int i = 0;; ++i) {
    const int it = item_of(i, nS + nR);
    if (it < 0) break;
    const int t = tid(), lane = t & 63, w = t >> 6, wm = w >> 1, wn = w & 1, r = lane & 31, h = lane >> 5;
    const bf16_t *ap[4], *bp[4];
    f32x16 acc[2][2]; zero_acc(acc);
    if (it < nS) {
      const int g = it & 3, n = c0 + (it >> 2);
      setup_ptrs(ap, (const bf16_t*)(p.ws + O_SW) + (size_t)(layer * 4 + g) * 16384, 128, 0);
      setup_ptrs(bp, (const bf16_t*)(p.ws + O_VNT) + (size_t)(g * NCH + n) * 16384, 128, 0);
      gemm_main(ap, bp, 2, smem, acc);
      const bf16_t* U = (const bf16_t*)(p.ws + O_U);
      bf16_t* Y = (bf16_t*)(p.ws + O_Y);
      const float* sb = p.sgu_b + (layer * 4 + g) * 128;
#pragma unroll
      for (int mi = 0; mi < 2; ++mi)
#pragma unroll
        for (int ni = 0; ni < 2; ++ni)
#pragma unroll
          for (int reg = 0; reg < 16; ++reg) {
            const int ii = 64 * wm + 32 * mi + (reg & 3) + 8 * (reg >> 2) + 4 * h, cc = 64 * wn + 32 * ni + r;
            const size_t tok = (size_t)n * 128 + ii;
            const unsigned uu = U[tok * 512 + g * 128 + cc];
            const float uf = __uint_as_float(uu << 16);
            Y[tok * DM + g * 128 + cc] = f2bf(uf * (acc[mi][ni][reg] + sb[ii]));
          }
    } else {
      const int j = it - nS, n = j % NCH, dh = j / NCH, dir = dh >> 2, hd = dh & 3;
      setup_ptrs(ap, (const bf16_t*)(p.ws + O_RVT) + (size_t)n * 128, TOK, hd * 128);
      setup_ptrs(bp, (const bf16_t*)(p.ws + (dir ? O_RKTB : O_RKTF)) + (size_t)n * 128, TOK, hd * 128);
      gemm_main(ap, bp, 2, smem, acc);
      float* UT = (float*)(p.ws + O_UT) + (size_t)(dh * NCH + n) * 16384;
#pragma unroll
      for (int mi = 0; mi < 2; ++mi)
#pragma unroll
        for (int ni = 0; ni < 2; ++ni)
#pragma unroll
          for (int reg = 0; reg < 16; ++reg) {
            const int vv = 64 * wm + 32 * mi + (reg & 3) + 8 * (reg >> 2) + 4 * h, dd = 64 * wn + 32 * ni + r;
            UT[vv * 128 + dd] = acc[mi][ni][reg];
          }
    }
  }
}

DI void scan_phase(const Params& p, int layer, char* smem) {
  const float* scal = (const float*)(p.ws + O_SCAL);
  const float* UT = (const float*)(p.ws + O_UT);
  bf16_t* ST = (bf16_t*)(p.ws + O_ST);
  for (int e = blockIdx.x * 512 + threadIdx.x; e < 8 * 16384; e += gridDim.x * 512) {
    const int dh = e >> 14, idx = e & 16383, dir = dh >> 2, hd = dh & 3;
    const float cdec = ex2(128.f * scal[layer * 8 + dir * 4 + hd] * LOG2E);
    float S = 0.f;
    for (int p0 = 0; p0 < NCH; p0 += 11) {
      float u[11];
#pragma unroll
      for (int k = 0; k < 11; ++k) {
        const int pp = p0 + k;
        const int n = dir == 0 ? pp : (pp < 2 ? 1 - pp : 67 - pp);
        u[k] = __builtin_nontemporal_load(UT + (size_t)(dh * NCH + n) * 16384 + idx);
      }
#pragma unroll
      for (int k = 0; k < 11; ++k) {
        const int pp = p0 + k;
        const int n = dir == 0 ? pp : (pp < 2 ? 1 - pp : 67 - pp);
        ST[(size_t)(dh * NCH + n) * 16384 + idx] = f2bf(S);
        S = S * cdec + u[k];
      }
    }
  }
  if (layer == 0) transpose_range(p, 6272 + 2048, 1216, blockIdx.x, gridDim.x, smem);
}

DI void retc_phase(const Params& p, int layer, char* smem) {
  const int c0 = layer == 0 ? 0 : 2;
  const int nI = (NCH - c0) * 4;
  const float* scal = (const float*)(p.ws + O_SCAL);
  bf16_t* Ps = (bf16_t*)(p.ws + O_PS) + (size_t)(2 * blockIdx.x + grp()) * 16384;
  for (int i = 0;; ++i) {
    const int it = item_of(i, nI);
    if (it < 0) break;
    const int t = tid(), lane = t & 63, w = t >> 6, wm = w >> 1, wn = w & 1, r = lane & 31, h = lane >> 5;
    const int hd = it & 3, n = c0 + (it >> 2);
    const float lgf = scal[layer * 8 + hd] * LOG2E, lgb = scal[layer * 8 + 4 + hd] * LOG2E;
    const bf16_t *ap[4], *bp[4];
    const bf16_t* RQ = (const bf16_t*)(p.ws + O_RQ) + (size_t)n * 128 * 512 + hd * 128;
    setup_ptrs(bp, RQ, 512, 0);
    {
      f32x16 sacc[2][2]; zero_acc(sacc);
      setup_ptrs(ap, (const bf16_t*)(p.ws + O_RK) + (size_t)n * 128 * 512 + hd * 128, 512, 0);
      gemm_main(ap, bp, 2, smem, sacc);
#pragma unroll
      for (int mi = 0; mi < 2; ++mi)
#pragma unroll
        for (int ni = 0; ni < 2; ++ni) {
          const int ii = 64 * wn + 32 * ni + r;
#pragma unroll
          for (int g = 0; g < 4; ++g) {
            float pv[4];
#pragma unroll
            for (int e = 0; e < 4; ++e) {
              const int jj = 64 * wm + 32 * mi + 8 * g + 4 * h + e;
              const float d = (ii > jj) ? ex2((float)(ii - jj) * lgf) : ((ii < jj) ? ex2((float)(jj - ii) * lgb) : 2.f);
              pv[e] = sacc[mi][ni][4 * g + e] * d;
            }
            u32x2 o; o.x = pack2(pv[0], pv[1]); o.y = pack2(pv[2], pv[3]);
            *(u32x2*)(Ps + ii * 128 + 64 * wm + 32 * mi + 8 * g + 4 * h) = o;
          }
        }
    }
    f32x16 acc[2][2]; zero_acc(acc);
    setup_ptrs(ap, (const bf16_t*)(p.ws + O_ST) + (size_t)((0 * 4 + hd) * NCH + n) * 16384, 128, 0);
    gemm_main(ap, bp, 2, smem, acc);
#pragma unroll
    for (int ni = 0; ni < 2; ++ni) {
      const int ii = 64 * wn + 32 * ni + r;
      const float f = ex2((float)(ii + 1) * lgf - (float)(128 - ii) * lgb);
#pragma unroll
      for (int mi = 0; mi < 2; ++mi)
#pragma unroll
        for (int reg = 0; reg < 16; ++reg) acc[mi][ni][reg] *= f;
    }
    setup_ptrs(ap, (const bf16_t*)(p.ws + O_ST) + (size_t)((1 * 4 + hd) * NCH + n) * 16384, 128, 0);
    gemm_main(ap, bp, 2, smem, acc);
#pragma unroll
    for (int ni = 0; ni < 2; ++ni) {
      const int ii = 64 * wn + 32 * ni + r;
      const float f = ex2((float)(128 - ii) * lgb);
#pragma unroll
      for (int mi = 0; mi < 2; ++mi)
#pragma unroll
        for (int reg = 0; reg < 16; ++reg) acc[mi][ni][reg] *= f;
    }
    __syncthreads();
    setup_ptrs(ap, (const bf16_t*)(p.ws + O_RVT) + (size_t)n * 128, TOK, hd * 128);
    setup_ptrs(bp, Ps, 128, 0);
    gemm_main(ap, bp, 2, smem, acc);
    dump_ct<true>(acc, (float*)smem);
    __syncthreads();
    {
      const int rr = lane & 31, half = lane >> 5, lrow = 32 * w + rr;
      const size_t tok = (size_t)n * 128 + lrow;
      const float* Ct = (const float*)smem;
      float v[8][8];
      float ss = 0.f;
#pragma unroll
      for (int k = 0; k < 8; ++k) {
        const f32x4 a = *(const f32x4*)(Ct + lrow * CTS + 8 * (half + 2 * k));
        const f32x4 b = *(const f32x4*)(Ct + lrow * CTS + 8 * (half + 2 * k) + 4);
        v[k][0] = a.x; v[k][1] = a.y; v[k][2] = a.z; v[k][3] = a.w; v[k][4] = b.x; v[k][5] = b.y; v[k][6] = b.z; v[k][7] = b.w;
#pragma unroll
        for (int e = 0; e < 8; ++e) ss += v[k][e] * v[k][e];
      }
      ss += __shfl_xor(ss, 32);
      const float rstd = rsqrtf(ss * (1.f / 128.f) + EPS);
      const bf16_t* RG = (const bf16_t*)(p.ws + O_RG) + tok * 512 + hd * 128;
      bf16_t* Y = (bf16_t*)(p.ws + O_Y) + tok * DM + 512 + hd * 128;
#pragma unroll
      for (int k = 0; k < 8; ++k) {
        const u32x4 gv = *(const u32x4*)(RG + 8 * (half + 2 * k));
        const unsigned gw[4] = {gv.x, gv.y, gv.z, gv.w};
#pragma unroll
        for (int e = 0; e < 8; ++e) {
          const float gf = __uint_as_float((e & 1) ? (gw[e >> 1] & 0xffff0000u) : (gw[e >> 1] << 16));
          v[k][e] = v[k][e] * rstd * gf;
        }
        store8(Y + 8 * (half + 2 * k), v[k]);
      }
    }
  }
  if (layer == 0) idle_transposes(p, nI >> 1, 6272, 2048, smem);
}

DI void outproj_phase(const Params& p, int layer, char* smem) {
  if (layer != 0) return;
  const bf16_t* Yb = (const bf16_t*)(p.ws + O_Y);
  const bf16_t* W = (const bf16_t*)(p.ws + O_WOUT) + (size_t)layer * DM * DM;
  const float* g1 = (const float*)(p.ws + O_MODS) + (size_t)(layer * 2 + 1) * 12288 + 2 * DM;
  float* X = (float*)(p.ws + O_X);
  for (int i = 0;; ++i) {
    const int it = item_of(i, 128);
    if (it < 0) break;
    const int t = tid(), lane = t & 63, w = t >> 6, wm = w >> 1, wn = w & 1, r = lane & 31, h = lane >> 5;
    const int L = it >> 2, ks = it & 3, mt = L & 1, nt = L >> 1;
    const bf16_t *ap[4], *bp[4];
    setup_ptrs(ap, Yb + ks * 512, DM, mt * 128); setup_ptrs(bp, W + ks * 512, DM, nt * 128);
    f32x16 acc[2][2]; zero_acc(acc);
    gemm_main(ap, bp, 8, smem, acc);
#pragma unroll
    for (int mi = 0; mi < 2; ++mi)
#pragma unroll
      for (int ni = 0; ni < 2; ++ni) {
        const int col = nt * 128 + 64 * wn + 32 * ni + r;
        const float gg = g1[col];
#pragma unroll
        for (int reg = 0; reg < 16; ++reg) {
          const int row = mt * 128 + 64 * wm + 32 * mi + (reg & 3) + 8 * (reg >> 2) + 4 * h;
          unsafeAtomicAdd(&X[(size_t)row * DM + col], gg * acc[mi][ni][reg]);
        }
      }
  }
}

DI void gateup_phase(const Params& p, int layer, char* smem) {
  if (layer != 0) return;
  const int mt0 = 0, nM = 2;
  const bf16_t* H = (const bf16_t*)(p.ws + O_H);
  const bf16_t* WG = (const bf16_t*)(p.ws + O_WG) + (size_t)layer * DFF * DM;
  const bf16_t* WU = (const bf16_t*)(p.ws + O_WU) + (size_t)layer * DFF * DM;
  bf16_t* HID = (bf16_t*)(p.ws + O_HID);
  for (int i = 0;; ++i) {
    const int L = item_of_rot(i, nM * 88);
    if (L < 0) break;
    const int t = tid(), lane = t & 63, w = t >> 6, wm = w >> 1, wn = w & 1, r = lane & 31, h = lane >> 5;
    int mt, nb; tile_mn(L, nM, 88, mt, nb); mt += mt0;
    const bf16_t *ap[4], *bp[4];
    setup_ptrs(ap, H, DM, mt * 128);
#pragma unroll
    for (int k = 0; k < 4; ++k) {
      const int rho = (t >> 3) + 32 * k;
      const int col = nb * 64 + 32 * (rho >> 6) + (rho & 31);
      bp[k] = (((rho >> 5) & 1) ? WU : WG) + (size_t)col * DM + (t & 7) * 8;
    }
    f32x16 acc[2][2]; zero_acc(acc);
    gemm_main(ap, bp, DM / 64, smem, acc);
#pragma unroll
    for (int mi = 0; mi < 2; ++mi)
#pragma unroll
      for (int reg = 0; reg < 16; ++reg) {
        const int row = mt * 128 + 64 * wm + 32 * mi + (reg & 3) + 8 * (reg >> 2) + 4 * h;
        const int col = nb * 64 + 32 * wn + r;
        HID[(size_t)row * DFF + col] = f2bf(silu(acc[mi][0][reg]) * acc[mi][1][reg]);
      }
  }
}

DI void down_phase(const Params& p, int layer, char* smem) {
  if (layer != 0) return;
  const bf16_t* HID = (const bf16_t*)(p.ws + O_HID);
  const bf16_t* W = (const bf16_t*)(p.ws + O_WD) + (size_t)layer * DM * DFF;
  const float* g2 = (const float*)(p.ws + O_MODS) + (size_t)(layer * 2 + 1) * 12288 + 5 * DM;
  float* X = (float*)(p.ws + O_X);
  for (int i = 0;; ++i) {
    const int it = item_of(i, 128);
    if (it < 0) break;
    const int t = tid(), lane = t & 63, w = t >> 6, wm = w >> 1, wn = w & 1, r = lane & 31, h = lane >> 5;
    const int L = it >> 2, ks = it & 3, mt = L & 1, nt = L >> 1;
    const bf16_t *ap[4], *bp[4];
    setup_ptrs(ap, HID + ks * 1408, DFF, mt * 128); setup_ptrs(bp, W + ks * 1408, DFF, nt * 128);
    f32x16 acc[2][2]; zero_acc(acc);
    gemm_main(ap, bp, 22, smem, acc);
#pragma unroll
    for (int mi = 0; mi < 2; ++mi)
#pragma unroll
      for (int ni = 0; ni < 2; ++ni) {
        const int col = nt * 128 + 64 * wn + 32 * ni + r;
        const float gg = g2[col];
#pragma unroll
        for (int reg = 0; reg < 16; ++reg) {
          const int row = mt * 128 + 64 * wm + 32 * mi + (reg & 3) + 8 * (reg >> 2) + 4 * h;
          unsafeAtomicAdd(&X[(size_t)row * DM + col], gg * acc[mi][ni][reg]);
        }
      }
  }
  idle_transposes(p, 64, 6272 + 2048 + 1216, 1216, smem);
}

DI void outproj256(const Params& p, int layer, char* smem) {
  const bf16_t* Yb = (const bf16_t*)(p.ws + O_Y);
  const bf16_t* W = (const bf16_t*)(p.ws + O_WOUT) + (size_t)layer * DM * DM;
  const float* g1 = (const float*)(p.ws + O_MODS) + (size_t)(layer * 2) * 12288 + 2 * DM;
  float* X = (float*)(p.ws + O_X);
  for (int i = 0;; ++i) {
    const int L = tile_of(i, 32 * 8);
    if (L < 0) break;
    int tm, tn; tile_mn(L, 32, 8, tm, tn);
    f32x16 acc[4][2]; zero_acc256(acc);
    gemm256((const char*)(Yb + (size_t)(256 + tm * 256) * DM), voff256(DM), (size_t)128 * DM, (const char*)(W + (size_t)(tn * 256) * DM), voff256(DM), (size_t)128 * DM, DM / 64, smem, acc);
    const int t = tid512(), lane = t & 63, w = t >> 6, wm = w >> 2, wn = w & 3, r = lane & 31, h = lane >> 5;
#pragma unroll
    for (int mi = 0; mi < 4; ++mi)
#pragma unroll
      for (int ni = 0; ni < 2; ++ni) {
        const int col = tn * 256 + 64 * wn + 32 * ni + r;
        const float gg = g1[col];
#pragma unroll
        for (int reg = 0; reg < 16; ++reg) {
          const int row = 256 + tm * 256 + 128 * wm + 32 * mi + (reg & 3) + 8 * (reg >> 2) + 4 * h;
          const float res = (layer == 0) ? __builtin_nontemporal_load(p.x + (size_t)(row - 256) * DM + col) : X[(size_t)row * DM + col];
          X[(size_t)row * DM + col] = res + gg * acc[mi][ni][reg];
        }
      }
  }
}

DI void gateup256(const Params& p, int layer, char* smem) {
  const bf16_t* H = (const bf16_t*)(p.ws + O_H);
  const bf16_t* WG = (const bf16_t*)(p.ws + O_WG) + (size_t)layer * DFF * DM;
  const bf16_t* WU = (const bf16_t*)(p.ws + O_WU) + (size_t)layer * DFF * DM;
  bf16_t* HID = (bf16_t*)(p.ws + O_HID);
  for (int i = 0;; ++i) {
    const int L = tile_of(i, 32 * 44);
    if (L < 0) break;
    int tm, nb; tile_mn(L, 32, 44, tm, nb);
    const int t = tid512(), lane = t & 63, w = t >> 6, wm = w >> 2, wn = w & 3, r = lane & 31, h = lane >> 5;
    const unsigned bvo = (unsigned)(((size_t)((t >> 3) & 31) * DM + (t & 7) * 8) * 2 + ((((t >> 3) >> 5) & 1) ? (O_WU - O_WG) : 0));
    f32x16 acc[4][2]; zero_acc256(acc);
    gemm256((const char*)(WG + (size_t)(nb * 128) * DM), bvo, (size_t)64 * DM, (const char*)(H + (size_t)(256 + tm * 256) * DM), voff256(DM), (size_t)128 * DM, DM / 64, smem, acc);
#pragma unroll
    for (int jj = 0; jj < 2; ++jj)
#pragma unroll
      for (int ni = 0; ni < 2; ++ni) {
        bf16_t* dst = HID + (size_t)(256 + tm * 256 + 64 * wn + 32 * ni + r) * DFF + nb * 128 + 64 * wm + 32 * jj + 4 * h;
#pragma unroll
        for (int g = 0; g < 4; ++g) {
          float v[4];
#pragma unroll
          for (int e = 0; e < 4; ++e) v[e] = silu(acc[2 * jj][ni][4 * g + e]) * acc[2 * jj + 1][ni][4 * g + e];
          u32x2 o; o.x = pack2(v[0], v[1]); o.y = pack2(v[2], v[3]);
          *(u32x2*)(dst + 8 * g) = o;
        }
      }
  }
}

DI void down256(const Params& p, int layer, char* smem) {
  const bf16_t* HID = (const bf16_t*)(p.ws + O_HID);
  const bf16_t* W = (const bf16_t*)(p.ws + O_WD) + (size_t)layer * DM * DFF;
  const float* g2 = (const float*)(p.ws + O_MODS) + (size_t)(layer * 2) * 12288 + 5 * DM;
  float* X = (float*)(p.ws + O_X);
  for (int i = 0;; ++i) {
    const int L = tile_of(i, 32 * 8);
    if (L < 0) break;
    int tm, tn; tile_mn(L, 32, 8, tm, tn);
    f32x16 acc[4][2]; zero_acc256(acc);
    gemm256((const char*)(HID + (size_t)(256 + tm * 256) * DFF), voff256(DFF), (size_t)128 * DFF, (const char*)(W + (size_t)(tn * 256) * DFF), voff256(DFF), (size_t)128 * DFF, DFF / 64, smem, acc);
    const int t = tid512(), lane = t & 63, w = t >> 6, wm = w >> 2, wn = w & 3, r = lane & 31, h = lane >> 5;
#pragma unroll
    for (int mi = 0; mi < 4; ++mi)
#pragma unroll
      for (int ni = 0; ni < 2; ++ni) {
        const int col = tn * 256 + 64 * wn + 32 * ni + r;
        const float gg = g2[col];
#pragma unroll
        for (int reg = 0; reg < 16; ++reg) {
          const int row = 256 + tm * 256 + 128 * wm + 32 * mi + (reg & 3) + 8 * (reg >> 2) + 4 * h;
          X[(size_t)row * DM + col] += gg * acc[mi][ni][reg];
        }
      }
  }
}

__global__ void __launch_bounds__(512) mega(Params p) {
  extern __shared__ __attribute__((aligned(16))) char smem[];
  char* sg = smem + grp() * GSM;
  __shared__ uint4 xb_words;
  unsigned* barw = (unsigned*)(p.ws + O_BAR);
  if (threadIdx.x == 0) xb_words = make_uint4(0u, 0u, 0u, 0u);
  __syncthreads();
  const XcdBarrier xb = xcd_barrier_post(barw, (volatile LAS unsigned*)&xb_words);
  for (int layer = 0; layer < 2; ++layer) {
    if (layer == 0) phase0(p, sg);
    xcd_barrier(xb);
    norm_phase(p, layer, 0);
    xcd_barrier(xb);
    inproj_phase(p, layer, smem);
    xcd_barrier(xb);
#if DUP == 1
    inproj_phase(p, layer, smem);
    xcd_barrier(xb);
#endif
    mix_phase(p, layer, smem, sg);
    xcd_barrier(xb);
#if DUP == 2
    mix_phase(p, layer, smem, sg);
    xcd_barrier(xb);
#endif
    scan_phase(p, layer, sg);
    xcd_barrier(xb);
#if DUP == 7
    scan_phase(p, layer, sg);
    xcd_barrier(xb);
#endif
#if DUP == 8
    for (int q = 0; q < 10; ++q) xcd_barrier(xb);
#endif
    retc_phase(p, layer, sg);
    xcd_barrier(xb);
#if DUP == 3
    retc_phase(p, layer, sg);
    xcd_barrier(xb);
#endif
    outproj256(p, layer, smem);
    outproj_phase(p, layer, sg);
    xcd_barrier(xb);
    norm_phase(p, layer, 1);
    xcd_barrier(xb);
    gateup256(p, layer, smem);
    gateup_phase(p, layer, sg);
    xcd_barrier(xb);
#if DUP == 4
    gateup256(p, layer, smem);
    xcd_barrier(xb);
#endif
    down256(p, layer, smem);
    down_phase(p, layer, sg);
  }
  xcd_barrier(xb);
  norm_phase(p, 1, 2);
}

extern "C" void kernel_launch(void* const* d_in, const int* in_sizes, int n_in, void* d_out, int out_size, void* d_ws, size_t ws_size,
                              hipStream_t stream) {
  static int grid_blocks = 0;
  if (!grid_blocks) {
    if (ws_size < WS_END) { fprintf(stderr, "kernel_launch: workspace too small: %zu < %zu\n", ws_size, (size_t)WS_END); grid_blocks = -1; return; }
    int dev = 0, cus = 0, per_cu = 0;
    hipGetDevice(&dev);
    hipDeviceGetAttribute(&cus, hipDeviceAttributeMultiprocessorCount, dev);
    hipFuncSetAttribute((const void*)mega, hipFuncAttributeMaxDynamicSharedMemorySize, SMEM_BYTES);
    hipOccupancyMaxActiveBlocksPerMultiprocessor(&per_cu, (const void*)mega, 512, SMEM_BYTES);
    if (per_cu < 1) { fprintf(stderr, "kernel_launch: occupancy query returned %d\n", per_cu); grid_blocks = -1; return; }
    if (per_cu > 1) per_cu = 1;
    grid_blocks = cus * per_cu;
    if (grid_blocks > 512) grid_blocks = 512;
  }
  if (grid_blocks < 0) return;
  Params p{};
  const float** f = (const float**)&p;
  for (int i = 0; i < 23; ++i) f[i] = (const float*)d_in[i];
  p.out = (float*)d_out;
  p.ws = (char*)d_ws;
  (void)hipMemsetAsync((char*)d_ws + O_BAR, 0, XCD_BAR_WORDS * 4, stream);
  void* args[] = {&p};
  hipError_t e = hipLaunchCooperativeKernel((const void*)mega, dim3(grid_blocks), dim3(512), args, SMEM_BYTES, stream);
  if (e != hipSuccess) fprintf(stderr, "cooperative launch failed: %s (grid %d)\n", hipGetErrorString(e), grid_blocks);
}
```

```cpp
#include <hip/hip_runtime.h>
#include <hip/hip_cooperative_groups.h>
#include <cstdio>
#include <cstdint>
namespace cg = cooperative_groups;

typedef unsigned short bf16_t;
typedef short bf16x8 __attribute__((ext_vector_type(8)));
typedef short s16x4 __attribute__((ext_vector_type(4)));
typedef float f32x16 __attribute__((ext_vector_type(16)));
typedef float f32x4 __attribute__((ext_vector_type(4)));
typedef float f32x2 __attribute__((ext_vector_type(2)));
typedef unsigned u32x4 __attribute__((ext_vector_type(4)));
typedef unsigned u32x2 __attribute__((ext_vector_type(2)));
#define DI __device__ __forceinline__
#define MFMA32(a, b, c) __builtin_amdgcn_mfma_f32_32x32x16_bf16((a), (b), (c), 0, 0, 0)

#ifndef DUP
#define DUP -1
#endif
constexpr int TOK = 8448, DM = 2048, DIN = 6144, DFF = 5632, NCH = 66;
constexpr float EPS = 1e-6f;
constexpr float LOG2E = 1.4426950408889634f;

constexpr size_t O_WIN = 0;
constexpr size_t O_WOUT = O_WIN + 2ull * DIN * DM * 2;
constexpr size_t O_WG = O_WOUT + 2ull * DM * DM * 2;
constexpr size_t O_WU = O_WG + 2ull * DFF * DM * 2;
constexpr size_t O_WD = O_WU + 2ull * DFF * DM * 2;
constexpr size_t O_MODS = O_WD + 2ull * DM * DFF * 2;
constexpr size_t O_TAB = O_MODS + 2ull * 2 * 12288 * 4;
constexpr size_t O_SW = O_TAB + 128ull * 32 * 8;
constexpr size_t O_SCAL = O_SW + 2ull * 4 * 16384 * 2;
constexpr size_t O_X = O_SCAL + 1024;
constexpr size_t O_H = O_X + (size_t)TOK * DM * 4;
constexpr size_t O_U = O_H + (size_t)TOK * DM * 2;
constexpr size_t SZ512 = (size_t)TOK * 512 * 2;
constexpr size_t O_VNT = O_U + SZ512;
constexpr size_t O_RQ = O_VNT + SZ512;
constexpr size_t O_RK = O_RQ + SZ512;
constexpr size_t O_RKTF = O_RK + SZ512;
constexpr size_t O_RKTB = O_RKTF + SZ512;
constexpr size_t O_RVT = O_RKTB + SZ512;
constexpr size_t O_RG = O_RVT + SZ512;
constexpr size_t O_DQ = O_RG + SZ512;
constexpr size_t O_DK = O_DQ + 2 * SZ512;
constexpr size_t O_DVT = O_DK + 2 * SZ512;
constexpr size_t O_Y = O_DVT + 2 * SZ512;
constexpr size_t O_HID = O_Y + (size_t)TOK * DM * 2;
constexpr size_t O_UT = O_HID + (size_t)TOK * DFF * 2;
constexpr size_t O_ST = O_UT + 8ull * NCH * 16384 * 4;
constexpr size_t O_PS = O_ST + 8ull * NCH * 16384 * 2;
constexpr size_t O_BAR = O_PS + 1024ull * 32768;
constexpr size_t WS_END = O_BAR + 16384;

constexpr int LROW = 144;
constexpr int TSZ = 128 * LROW;
constexpr int SMEM_BYTES = 8 * TSZ;
constexpr int CTS = 132;

struct Params {
  const float *x, *c, *ctx, *c_ctx, *w_ada, *b_ada, *norm1_g, *w_in, *sgu_w, *sgu_b, *dec_f, *dec_b;
  const float *lq1, *lk1, *lq2, *lk2, *subln, *w_out, *norm2_g, *w_gate, *w_up, *w_down, *final_g;
  float* out;
  char* ws;
};

typedef __bf16 bf16v2 __attribute__((ext_vector_type(2)));
DI unsigned short f2bf(float x) { return __builtin_bit_cast(unsigned short, (__bf16)x); }
DI unsigned pack2(float lo, float hi) { bf16v2 v = {(__bf16)lo, (__bf16)hi}; return __builtin_bit_cast(unsigned, v); }
DI float gelu_tanh(float x) { float u = 0.7978845608028654f * (x + 0.044715f * x * x * x); float e = __expf(2.f * u); return x * (1.f - __builtin_amdgcn_rcpf(e + 1.f)); }
DI float silu(float x) { return x * __builtin_amdgcn_rcpf(1.f + __expf(-x)); }
DI float ex2(float x) { return __builtin_amdgcn_exp2f(x); }
DI int tid() { int t = threadIdx.x & 255; asm volatile("" : "+v"(t)); return t; }
DI int tid512() { int t = threadIdx.x; asm volatile("" : "+v"(t)); return t; }
DI int grp() { return __builtin_amdgcn_readfirstlane((int)(threadIdx.x >> 8)); }
constexpr int GSM = 73728;

#define XB_TMO      128
#define XB_XCNT(j)  (256  + 64 * (j))
#define XB_XSUB(j)  (1280 + 64 * (j))
#define XB_XGEN(j)  (2304 + 64 * (j))
#define XB_TOP      3328
#define XB_TOPGEN   3392
#define XCD_BAR_WORDS 3456
#define XB_SPIN_CAP (1u << 18)
#define LAS __attribute__((address_space(3)))

__device__ __forceinline__ unsigned xb_ld(unsigned* p)              { return __hip_atomic_load(p, __ATOMIC_RELAXED, __HIP_MEMORY_SCOPE_AGENT); }
__device__ __forceinline__ unsigned xb_add(unsigned* p, unsigned v) { return __hip_atomic_fetch_add(p, v, __ATOMIC_RELAXED, __HIP_MEMORY_SCOPE_AGENT); }
__device__ __forceinline__ unsigned xb_xcc_id() { return (unsigned)__builtin_amdgcn_s_getreg((3 << 11) | 20) & 0xFu; }
#define XB_SPIN(cond, bar) do { unsigned _sp = 0; while (cond) { __builtin_amdgcn_s_sleep(1); \
    if ((++_sp & 255u) == 0u) { if (xb_ld(&(bar)[XB_TMO])) break; if (_sp > XB_SPIN_CAP) { atomicAdd(&(bar)[XB_TMO], 1u); break; } } } } while (0)

struct XcdBarrier {
    unsigned* bar; unsigned x;
    volatile LAS unsigned* st;
};

__device__ __forceinline__ XcdBarrier xcd_barrier_post(unsigned* bar, volatile LAS unsigned* st) {
    XcdBarrier b; b.bar = bar; b.x = xb_xcc_id(); b.st = st;
    if (threadIdx.x == 0) (void)xb_add(&bar[XB_XCNT(b.x)], 1u);
    return b;
}
__device__ __forceinline__ void xcd_barrier_complete(unsigned* bar, unsigned x, unsigned& nloc, unsigned& nx) {
    const unsigned G = gridDim.x * gridDim.y * gridDim.z;
    unsigned sum, cnt, mine, sp = 0u;
    for (;;) {
        sum = 0u; cnt = 0u; mine = 0u;
#pragma unroll
        for (unsigned j = 0; j < 16; ++j) { const unsigned c = xb_ld(&bar[XB_XCNT(j)]); sum += c; cnt += (c > 0u) ? 1u : 0u; mine = (j == x) ? c : mine; }
        if (sum == G) break;
        __builtin_amdgcn_s_sleep(1);
        if ((++sp & 255u) == 0u) { if (xb_ld(&bar[XB_TMO])) break; if (sp > XB_SPIN_CAP) { atomicAdd(&bar[XB_TMO], 1u); break; } }
    }
    nloc = mine > 0u ? mine : 1u; nx = cnt > 0u ? cnt : 1u;
}

__device__ __forceinline__ void xcd_barrier(const XcdBarrier& b) {
    asm volatile("s_waitcnt vmcnt(0)" ::: "memory");
    __syncthreads();
    if (threadIdx.x == 0) {
        unsigned* bar = b.bar;
        __builtin_amdgcn_s_waitcnt(0);
        unsigned nloc = b.st[0], nx = b.st[1];
        if (nloc == 0u) { xcd_barrier_complete(bar, b.x, nloc, nx); b.st[0] = nloc; b.st[1] = nx; }
        const unsigned old = xb_add(&bar[XB_XSUB(b.x)], 1u);
        const unsigned gen = old / nloc;
        if (old + 1u == (gen + 1u) * nloc) {
            __builtin_amdgcn_fence(__ATOMIC_RELEASE, "agent");
            asm volatile("s_waitcnt vmcnt(0)" ::: "memory");
            const unsigned og = xb_add(&bar[XB_TOP], 1u);
            const unsigned tg = og / nx;
            if (og + 1u == (tg + 1u) * nx) xb_add(&bar[XB_TOPGEN], 1u);
            else XB_SPIN(xb_ld(&bar[XB_TOPGEN]) == tg, bar);
            __builtin_amdgcn_fence(__ATOMIC_ACQUIRE, "agent");
            xb_add(&bar[XB_XGEN(b.x)], 1u);
            asm volatile("s_waitcnt vmcnt(0)" ::: "memory");
        } else {
            XB_SPIN(xb_ld(&bar[XB_XGEN(b.x)]) == gen, bar);
            __builtin_amdgcn_fence(__ATOMIC_ACQUIRE, "agent");
            asm volatile("s_waitcnt vmcnt(0)" ::: "memory");
        }
    }
    __syncthreads();
}


DI int tile_of(int i, int ntiles) {
  const int G = gridDim.x, b = blockIdx.x;
  if (G & 7) { int L = b + i * G; return L < ntiles ? L : -1; }
  const int q = (ntiles + 7) >> 3, nb = G >> 3, x = b & 7, loc = (b >> 3) + i * nb;
  if (loc >= q) return -1;
  const int L = x * q + loc;
  return L < ntiles ? L : -1;
}
DI int item_of(int i, int nitems) {
  const int j = tile_of(i, nitems >> 1);
  return j < 0 ? -1 : 2 * j + grp();
}
DI int item_of_rot(int i, int nitems) {
  const int G = gridDim.x, b = (blockIdx.x + (G >> 1)) % G, npairs = nitems >> 1;
  int j;
  if (G & 7) { j = b + i * G; if (j >= npairs) return -1; }
  else {
    const int q = (npairs + 7) >> 3, nb = G >> 3, x = b & 7, loc = (b >> 3) + i * nb;
    if (loc >= q) return -1;
    j = x * q + loc;
    if (j >= npairs) return -1;
  }
  return 2 * j + grp();
}
constexpr int GM = 4;
DI void tile_mn(int L, int nM, int nN, int& mt, int& nt) {
  const int per = GM * nN, g = L / per, fm = g * GM;
  const int gsz = (nM - fm) < GM ? (nM - fm) : GM;
  const int rem = L - g * per;
  mt = fm + rem % gsz; nt = rem / gsz;
}

DI void setup_ptrs(const bf16_t* (&ptr)[4], const bf16_t* base, size_t ld, int row0) {
  const int t = tid();
#pragma unroll
  for (int i = 0; i < 4; ++i) ptr[i] = base + (size_t)(row0 + (t >> 3) + 32 * i) * ld + (t & 7) * 8;
}

DI void gemm_main(const bf16_t* (&ap)[4], const bf16_t* (&bp)[4], int nk, char* smem, f32x16 (&acc)[2][2]) {
  const int t = tid(), lane = t & 63, w = t >> 6, wm = w >> 1, wn = w & 1, r = lane & 31, h = lane >> 5;
  const int soff = (t >> 3) * LROW + (t & 7) * 16;
  const int aoff = (64 * wm + r) * LROW + h * 16, boff = TSZ + (64 * wn + r) * LROW + h * 16;
  u32x4 ra0[4], rb0[4], ra1[4], rb1[4];
#define G_LOAD(RA, RB, KT) { _Pragma("unroll") for (int i = 0; i < 4; ++i) { RA[i] = *(const u32x4*)(ap[i] + (KT) * 64); RB[i] = *(const u32x4*)(bp[i] + (KT) * 64); } }
#define G_STORE(RA, RB, ST) { char* D_ = smem + (ST) * 2 * TSZ; _Pragma("unroll") for (int i = 0; i < 4; ++i) { *(u32x4*)(D_ + soff + i * 32 * LROW) = RA[i]; *(u32x4*)(D_ + TSZ + soff + i * 32 * LROW) = RB[i]; } }
#define G_COMPUTE(ST) { const char* S_ = smem + (ST) * 2 * TSZ; _Pragma("unroll") for (int s = 0; s < 4; ++s) { \
      const bf16x8 a0 = *(const bf16x8*)(S_ + aoff + s * 32); const bf16x8 a1 = *(const bf16x8*)(S_ + aoff + 32 * LROW + s * 32); \
      const bf16x8 b0 = *(const bf16x8*)(S_ + boff + s * 32); const bf16x8 b1 = *(const bf16x8*)(S_ + boff + 32 * LROW + s * 32); \
      acc[0][0] = MFMA32(a0, b0, acc[0][0]); acc[0][1] = MFMA32(a0, b1, acc[0][1]); acc[1][0] = MFMA32(a1, b0, acc[1][0]); acc[1][1] = MFMA32(a1, b1, acc[1][1]); } }
  G_LOAD(ra0, rb0, 0);
  G_LOAD(ra1, rb1, 1);
  __syncthreads();
  G_STORE(ra0, rb0, 0);
  __syncthreads();
  const int last = nk - 1;
  for (int kt = 0; kt < nk; kt += 2) {
    const int k2 = (kt + 2 < last) ? kt + 2 : last, k3 = (kt + 3 < last) ? kt + 3 : last;
    G_LOAD(ra0, rb0, k2);
    __builtin_amdgcn_sched_barrier(0);
    G_COMPUTE(0);
    G_STORE(ra1, rb1, 1);
    __syncthreads();
    G_LOAD(ra1, rb1, k3);
    __builtin_amdgcn_sched_barrier(0);
    G_COMPUTE(1);
    G_STORE(ra0, rb0, 0);
    __syncthreads();
  }
#undef G_LOAD
#undef G_STORE
#undef G_COMPUTE
}


constexpr int T2 = 256 * LROW;
DI void setup_ptrs256(const bf16_t* (&ptr)[4], const bf16_t* base, size_t ld, int row0) {
  const int t = tid512();
#pragma unroll
  for (int i = 0; i < 4; ++i) ptr[i] = base + (size_t)(row0 + (t >> 3) + 64 * i) * ld + (t & 7) * 8;
}
DI const bf16_t* base256(const bf16_t* base, size_t ld, int row0) { const int t = tid512(); return base + (size_t)(row0 + (t >> 3)) * ld + (t & 7) * 8; }
DI void zero_acc256(f32x16 (&acc)[4][2]) {
#pragma unroll
  for (int a = 0; a < 4; ++a)
#pragma unroll
    for (int b = 0; b < 2; ++b)
#pragma unroll
      for (int i = 0; i < 16; ++i) acc[a][b][i] = 0.f;
}
DI void gemm256(const char* a_u, unsigned a_voff, size_t astep, const char* b_u, unsigned b_voff, size_t bstep, int nk, char* smem, f32x16 (&acc)[4][2]) {
  asm volatile("" : "+s"(nk));
  const int t = tid512(), lane = t & 63, w = t >> 6, wm = w >> 2, wn = w & 3, r = lane & 31, h = lane >> 5;
  const int soff = (t >> 3) * LROW + (t & 7) * 16;
  const int aoff = (128 * wm + r) * LROW + h * 16, boff = T2 + (64 * wn + r) * LROW + h * 16;
  u32x4 ra[4], rb[4];
#pragma unroll
  for (int i = 0; i < 4; ++i) { ra[i] = *(const u32x4*)(a_u + i * astep + a_voff); rb[i] = *(const u32x4*)(b_u + i * bstep + b_voff); }
  __syncthreads();
#pragma unroll
  for (int i = 0; i < 4; ++i) { *(u32x4*)(smem + soff + i * 64 * LROW) = ra[i]; *(u32x4*)(smem + T2 + soff + i * 64 * LROW) = rb[i]; }
  const int last = nk - 1;
  {
    const int k1 = last < 1 ? last : 1;
#pragma unroll
    for (int i = 0; i < 4; ++i) { ra[i] = *(const u32x4*)(a_u + i * astep + k1 * 128 + a_voff); rb[i] = *(const u32x4*)(b_u + i * bstep + k1 * 128 + b_voff); }
  }
  __syncthreads();
  for (int kt = 0; kt < nk; ++kt) {
    const int cur = kt & 1, k2 = (kt + 2 < last) ? kt + 2 : last;
    const char* S = smem + cur * 2 * T2;
    char* D = smem + (cur ^ 1) * 2 * T2;
    const char* an = a_u + (size_t)k2 * 128;
    const char* bn = b_u + (size_t)k2 * 128;
#pragma unroll
    for (int s = 0; s < 4; ++s) {
      bf16x8 a[4], b[2];
#pragma unroll
      for (int mi = 0; mi < 4; ++mi) a[mi] = *(const bf16x8*)(S + aoff + mi * 32 * LROW + s * 32);
#pragma unroll
      for (int ni = 0; ni < 2; ++ni) b[ni] = *(const bf16x8*)(S + boff + ni * 32 * LROW + s * 32);
      *(u32x4*)(D + soff + s * 64 * LROW) = ra[s];
      *(u32x4*)(D + T2 + soff + s * 64 * LROW) = rb[s];
      ra[s] = *(const u32x4*)(an + s * astep + a_voff);
      rb[s] = *(const u32x4*)(bn + s * bstep + b_voff);
#pragma unroll
      for (int mi = 0; mi < 4; ++mi)
#pragma unroll
        for (int ni = 0; ni < 2; ++ni) acc[mi][ni] = MFMA32(a[mi], b[ni], acc[mi][ni]);
    }
    __syncthreads();
  }
}
DI unsigned voff256(size_t ld) { const int t = tid512(); return (unsigned)(((size_t)(t >> 3) * ld + (t & 7) * 8) * 2); }

DI void zero_acc(f32x16 (&acc)[2][2]) {
#pragma unroll
  for (int a = 0; a < 2; ++a)
#pragma unroll
    for (int b = 0; b < 2; ++b)
#pragma unroll
      for (int i = 0; i < 16; ++i) acc[a][b][i] = 0.f;
}

template <bool TR> DI void dump_ct(const f32x16 (&acc)[2][2], float* Ct) {
  const int t = tid(), lane = t & 63, w = t >> 6, wm = w >> 1, wn = w & 1, r = lane & 31, h = lane >> 5;
#pragma unroll
  for (int mi = 0; mi < 2; ++mi)
#pragma unroll
    for (int ni = 0; ni < 2; ++ni) {
      const int col = 64 * wn + 32 * ni + r;
      if (TR) {
#pragma unroll
        for (int g = 0; g < 4; ++g) {
          const int row = 64 * wm + 32 * mi + 8 * g + 4 * h;
          f32x4 v = {acc[mi][ni][4 * g], acc[mi][ni][4 * g + 1], acc[mi][ni][4 * g + 2], acc[mi][ni][4 * g + 3]};
          *(f32x4*)(Ct + col * CTS + row) = v;
        }
      } else {
#pragma unroll
        for (int reg = 0; reg < 16; ++reg) {
          const int row = 64 * wm + 32 * mi + (reg & 3) + 8 * (reg >> 2) + 4 * h;
          Ct[row * CTS + col] = acc[mi][ni][reg];
        }
      }
    }
}

DI void store8(bf16_t* dst, const float (&v)[8]) {
  u32x4 o; o.x = pack2(v[0], v[1]); o.y = pack2(v[2], v[3]); o.z = pack2(v[4], v[5]); o.w = pack2(v[6], v[7]);
  *(u32x4*)dst = o;
}

DI void transpose_tile(const float* src, bf16_t* dst, int K, int N, int kt, int nt, char* smem) {
  float* T = (float*)smem;
  const int t = tid();
  f32x4 v[8];
#pragma unroll
  for (int i = 0; i < 8; ++i) v[i] = __builtin_nontemporal_load((const f32x4*)(src + (size_t)(kt * 64 + (t >> 5) + 8 * i) * N + nt * 128 + (t & 31) * 4));
  __syncthreads();
#pragma unroll
  for (int i = 0; i < 8; ++i) *(f32x4*)(T + ((t >> 5) + 8 * i) * 132 + (t & 31) * 4) = v[i];
  __syncthreads();
  const int n = t >> 1, kq = (t & 1) * 32;
  bf16_t* d = dst + (size_t)(nt * 128 + n) * K + kt * 64 + kq;
#pragma unroll
  for (int j = 0; j < 4; ++j) {
    float w[8];
#pragma unroll
    for (int e = 0; e < 8; ++e) w[e] = T[(kq + 8 * j + e) * 132 + n];
    store8(d + 8 * j, w);
  }
}

DI void adaln_item(const Params& p, int it, char* smem) {
  const int l = it / 192, n0 = (it % 192) * 64;
  float* sc = (float*)smem;
  float* sx = sc + 2048;
  float* red = sx + 2048;
  const int t = tid();
  __syncthreads();
  for (int k = t; k < 2048; k += 256) { sc[k] = silu(p.c[k]); sx[k] = silu(p.c_ctx[k]); }
  __syncthreads();
  const int col = t & 63, kq = t >> 6;
  const float* wp = p.w_ada + (size_t)l * 2048 * 12288 + (size_t)(kq * 512) * 12288 + n0 + col;
  float a0 = 0.f, a1 = 0.f;
  for (int k = 0; k < 512; k += 32) {
    float wv[32];
#pragma unroll
    for (int e = 0; e < 32; ++e) wv[e] = __builtin_nontemporal_load(wp + (size_t)(k + e) * 12288);
#pragma unroll
    for (int e = 0; e < 32; ++e) { a0 += sc[kq * 512 + k + e] * wv[e]; a1 += sx[kq * 512 + k + e] * wv[e]; }
  }
  red[(kq * 64 + col) * 2] = a0; red[(kq * 64 + col) * 2 + 1] = a1;
  __syncthreads();
  if (t < 128) {
    const int cc = t & 63, s = t >> 6;
    float sum = 0.f;
#pragma unroll
    for (int q = 0; q < 4; ++q) sum += red[(q * 64 + cc) * 2 + s];
    float* mods = (float*)(p.ws + O_MODS);
    mods[(size_t)(l * 2 + s) * 12288 + n0 + cc] = sum + p.b_ada[l * 12288 + n0 + cc];
  }
}

DI void misc_item(const Params& p) {
  const int t = tid();
  f32x2* TAB = (f32x2*)(p.ws + O_TAB);
  for (int e = t; e < 4096; e += 256) {
    const int pos = e >> 5, j = e & 31;
    const float fr = powf(10000.f, -(float)j / 32.f);
    const float ang = (float)pos * fr;
    const double a = (double)ang;
    const double kk = rint(a * 0.15915494309189535);
    const float red = (float)(a - kk * 6.283185307179586);
    f32x2 cs; cs.x = __cosf(red); cs.y = __sinf(red);
    TAB[j * 128 + pos] = cs;
  }
  float* scal = (float*)(p.ws + O_SCAL);
  if (t < 16) {
    const int l = t >> 3, dir = (t >> 2) & 1, hd = t & 3;
    const float xx = (dir ? p.dec_b : p.dec_f)[l * 4 + hd];
    scal[t] = -log1pf(expf(-xx));
  }
  if (t == 16 || t == 17) {
    const int l = t - 16;
    float d1 = 0.f, d2 = 0.f;
    for (int k = 0; k < 64; ++k) { d1 += p.lq1[l * 64 + k] * p.lk1[l * 64 + k]; d2 += p.lq2[l * 64 + k] * p.lk2[l * 64 + k]; }
    const float lam_init = 0.8f - 0.6f * expf(-0.3f * (float)l);
    scal[16 + l] = expf(d1) - expf(d2) + lam_init;
    scal[18 + l] = lam_init;
  }
}

DI void transpose_item(const Params& p, int idx, char* smem) {
  const int l = idx / 6272; int r = idx % 6272;
  if (r < 1536) transpose_tile(p.w_in + (size_t)l * DM * DIN, (bf16_t*)(p.ws + O_WIN) + (size_t)l * DIN * DM, DM, DIN, r / 48, r % 48, smem);
  else if (r < 2048) { r -= 1536; transpose_tile(p.w_out + (size_t)l * DM * DM, (bf16_t*)(p.ws + O_WOUT) + (size_t)l * DM * DM, DM, DM, r / 16, r % 16, smem); }
  else if (r < 3456) { r -= 2048; transpose_tile(p.w_gate + (size_t)l * DM * DFF, (bf16_t*)(p.ws + O_WG) + (size_t)l * DFF * DM, DM, DFF, r / 44, r % 44, smem); }
  else if (r < 4864) { r -= 3456; transpose_tile(p.w_up + (size_t)l * DM * DFF, (bf16_t*)(p.ws + O_WU) + (size_t)l * DFF * DM, DM, DFF, r / 44, r % 44, smem); }
  else { r -= 4864; transpose_tile(p.w_down + (size_t)l * DFF * DM, (bf16_t*)(p.ws + O_WD) + (size_t)l * DM * DFF, DFF, DM, r / 16, r % 16, smem); }
}
DI void transpose_range(const Params& p, int first, int nitems, int my, int nblk, char* smem) {
  for (int j = my; j < (nitems >> 1); j += nblk) transpose_item(p, first + 2 * j + grp(), smem);
}
DI void idle_transposes(const Params& p, int busy_pairs, int first, int nitems, char* smem) {
  const int G = gridDim.x, b = blockIdx.x;
  int my, n_idle;
  if (G & 7) { n_idle = G - busy_pairs; my = b - busy_pairs; }
  else { const int q = (busy_pairs + 7) >> 3, nb = G >> 3; n_idle = (nb - q) * 8; my = ((b >> 3) - q) * 8 + (b & 7); if ((b >> 3) < q) my = -1; }
  if (n_idle <= 0) { n_idle = G; my = b; }
  if (my < 0) return;
  transpose_range(p, first, nitems, my, n_idle, smem);
}

DI void phase0(const Params& p, char* smem) {
  const int NT = 384 + 32 + 2 + 2048;
  for (int j = blockIdx.x; j < NT / 2; j += gridDim.x) {
    const int it = 2 * j + grp();
    if (it < 384) { adaln_item(p, it, smem); continue; }
    if (it < 416) {
      const int base = (it - 384) * 4096;
      bf16_t* SW = (bf16_t*)(p.ws + O_SW);
      for (int e = tid(); e < 4096; e += 256) SW[base + e] = f2bf(p.sgu_w[base + e]);
      continue;
    }
    if (it == 416) { misc_item(p); continue; }
    if (it == 417) continue;
    transpose_item(p, it - 418, smem);
  }
}

DI void norm_phase(const Params& p, int layer, int which) {
  const int lane = threadIdx.x & 63;
  const int wg = blockIdx.x * 8 + (threadIdx.x >> 6), nw = gridDim.x * 8;
  const float* mods = (const float*)(p.ws + O_MODS);
  const float* X = (const float*)(p.ws + O_X);
  bf16_t* H = (bf16_t*)(p.ws + O_H);
  const int row0 = (which == 2 || (layer == 1 && which == 1)) ? 256 : 0;
  for (int row = row0 + wg; row < TOK; row += nw) {
    const float* src;
    if (which == 0 && layer == 0) src = (row < 256) ? (p.ctx + (size_t)row * DM) : (p.x + (size_t)(row - 256) * DM);
    else src = X + (size_t)row * DM;
    f32x4 v[8];
    float ss = 0.f;
#pragma unroll
    for (int i = 0; i < 8; ++i) { v[i] = *(const f32x4*)(src + (lane + 64 * i) * 4); ss += v[i].x * v[i].x + v[i].y * v[i].y + v[i].z * v[i].z + v[i].w * v[i].w; }
    if (which == 0 && layer == 0 && row < 256) {
#pragma unroll
      for (int i = 0; i < 8; ++i) *(f32x4*)((float*)(p.ws + O_X) + (size_t)row * DM + (lane + 64 * i) * 4) = v[i];
    }
#pragma unroll
    for (int o = 32; o >= 1; o >>= 1) ss += __shfl_xor(ss, o);
    const float rstd = rsqrtf(ss * (1.f / DM) + EPS);
    if (which == 2) {
#pragma unroll
      for (int i = 0; i < 8; ++i) {
        const int col = (lane + 64 * i) * 4;
        const f32x4 g = *(const f32x4*)(p.final_g + col);
        f32x4 o = {v[i].x * rstd * g.x, v[i].y * rstd * g.y, v[i].z * rstd * g.z, v[i].w * rstd * g.w};
        __builtin_nontemporal_store(o, (f32x4*)(p.out + (size_t)(row - 256) * DM + col));
      }
    } else {
      const float* gw = (which == 0 ? p.norm1_g : p.norm2_g) + layer * DM;
      const float* mb = mods + (size_t)(layer * 2 + (row < 256 ? 1 : 0)) * 12288 + (which == 0 ? 0 : 3 * DM);
#pragma unroll
      for (int i = 0; i < 8; ++i) {
        const int col = (lane + 64 * i) * 4;
        const f32x4 g = *(const f32x4*)(gw + col);
        const f32x4 sh = *(const f32x4*)(mb + col);
        const f32x4 sc = *(const f32x4*)(mb + DM + col);
        const float o0 = v[i].x * rstd * g.x * (1.f + sc.x) + sh.x, o1 = v[i].y * rstd * g.y * (1.f + sc.y) + sh.y;
        const float o2 = v[i].z * rstd * g.z * (1.f + sc.z) + sh.z, o3 = v[i].w * rstd * g.w * (1.f + sc.w) + sh.w;
        u32x2 o; o.x = pack2(o0, o1); o.y = pack2(o2, o3);
        *(u32x2*)(H + (size_t)row * DM + col) = o;
      }
    }
  }
}

DI void inproj_epi(const Params& p, int layer, int mt, int nt, const float* Ct, int cts = CTS) {
  const int t = tid(), lane = t & 63, w = t >> 6, rr = lane & 31, half = lane >> 5;
  const int lrow = 32 * w + rr, tok = mt * 128 + lrow;
  const bool is_ctx = mt < 2;
  const int tl = tok - 256, prow = (tl >> 6) & 127, pcol = tl & 63;
  const f32x2* TAB = (const f32x2*)(p.ws + O_TAB);
  const float* scal = (const float*)(p.ws + O_SCAL);
  float v[8][8];
#pragma unroll
  for (int i = 0; i < 8; ++i) {
    const f32x4 a = *(const f32x4*)(Ct + lrow * cts + 8 * (half + 2 * i));
    const f32x4 b = *(const f32x4*)(Ct + lrow * cts + 8 * (half + 2 * i) + 4);
    v[i][0] = a.x; v[i][1] = a.y; v[i][2] = a.z; v[i][3] = a.w; v[i][4] = b.x; v[i][5] = b.y; v[i][6] = b.z; v[i][7] = b.w;
  }
  if (nt < 4) {
    bf16_t* U = (bf16_t*)(p.ws + O_U) + (size_t)tok * 512 + nt * 128;
#pragma unroll
    for (int i = 0; i < 8; ++i) {
#pragma unroll
      for (int e = 0; e < 8; ++e) v[i][e] = gelu_tanh(v[i][e]);
      store8(U + 8 * (half + 2 * i), v[i]);
    }
  } else if (nt < 8) {
    const int g = nt - 4;
    float ss = 0.f;
#pragma unroll
    for (int i = 0; i < 8; ++i)
#pragma unroll
      for (int e = 0; e < 8; ++e) { v[i][e] = gelu_tanh(v[i][e]); ss += v[i][e] * v[i][e]; }
    ss += __shfl_xor(ss, 32);
    const float rstd = rsqrtf(ss * (1.f / 128.f) + EPS);
    bf16_t* VNT = (bf16_t*)(p.ws + O_VNT) + (size_t)(g * NCH + mt) * 16384 + lrow;
#pragma unroll
    for (int i = 0; i < 8; ++i)
#pragma unroll
      for (int e = 0; e < 8; ++e) VNT[(8 * (half + 2 * i) + e) * 128] = f2bf(v[i][e] * rstd);
  } else if (nt < 16) {
    const int isk = nt >= 12, hd = (nt - 8) & 3;
    if (!is_ctx) {
#pragma unroll
      for (int ii = 0; ii < 4; ++ii) {
        const int i = (ii & 1) + 4 * (ii >> 1);
        const int pos = (i < 4) ? prow : pcol;
#pragma unroll
        for (int e = 0; e < 8; ++e) {
          const int c = 8 * (half + 2 * i) + e;
          const f32x2 cs = TAB[(c & 31) * 128 + pos];
          const float x1 = v[i][e], x2 = v[i + 2][e];
          v[i][e] = x1 * cs.x - x2 * cs.y; v[i + 2][e] = x1 * cs.y + x2 * cs.x;
        }
      }
    }
    if (!isk) {
      bf16_t* RQ = (bf16_t*)(p.ws + O_RQ) + (size_t)tok * 512 + hd * 128;
#pragma unroll
      for (int i = 0; i < 8; ++i) store8(RQ + 8 * (half + 2 * i), v[i]);
    } else {
      const float scale = 0.08838834764831845f;
      const float lgf = scal[layer * 8 + hd], lgb = scal[layer * 8 + 4 + hd];
      const float df = ex2((float)(127 - lrow) * lgf * LOG2E), db = ex2((float)lrow * lgb * LOG2E);
      bf16_t* RK = (bf16_t*)(p.ws + O_RK) + (size_t)tok * 512 + hd * 128;
      bf16_t* KF = (bf16_t*)(p.ws + O_RKTF) + (size_t)(hd * 128) * TOK + tok;
      bf16_t* KB = (bf16_t*)(p.ws + O_RKTB) + (size_t)(hd * 128) * TOK + tok;
#pragma unroll
      for (int i = 0; i < 8; ++i) {
#pragma unroll
        for (int e = 0; e < 8; ++e) {
          v[i][e] *= scale;
          const int c = 8 * (half + 2 * i) + e;
          KF[(size_t)c * TOK] = f2bf(v[i][e] * df);
          KB[(size_t)c * TOK] = f2bf(v[i][e] * db);
        }
        store8(RK + 8 * (half + 2 * i), v[i]);
      }
    }
  } else if (nt < 20) {
    const int hd = nt - 16;
    bf16_t* VT = (bf16_t*)(p.ws + O_RVT) + (size_t)(hd * 128) * TOK + tok;
#pragma unroll
    for (int i = 0; i < 8; ++i)
#pragma unroll
      for (int e = 0; e < 8; ++e) VT[(size_t)(8 * (half + 2 * i) + e) * TOK] = f2bf(v[i][e]);
  } else if (nt < 24) {
    const int hd = nt - 20;
    bf16_t* RG = (bf16_t*)(p.ws + O_RG) + (size_t)tok * 512 + hd * 128;
#pragma unroll
    for (int i = 0; i < 8; ++i) {
#pragma unroll
      for (int e = 0; e < 8; ++e) v[i][e] = silu(v[i][e]);
      store8(RG + 8 * (half + 2 * i), v[i]);
    }
  } else if (nt < 40) {
    const int isk = nt >= 32, hd = (nt - 24) & 7;
    if (!is_ctx) {
#pragma unroll
      for (int i = 0; i < 8; i += 2) {
        const int pos = (i & 2) ? pcol : prow;
#pragma unroll
        for (int e = 0; e < 8; ++e) {
          const int c = 8 * (half + 2 * i) + e;
          const f32x2 cs = TAB[2 * (c & 15) * 128 + pos];
          const float x1 = v[i][e], x2 = v[i + 1][e];
          v[i][e] = x1 * cs.x - x2 * cs.y; v[i + 1][e] = x1 * cs.y + x2 * cs.x;
        }
      }
    }
    bf16_t* D = (bf16_t*)(p.ws + (isk ? O_DK : O_DQ)) + (size_t)tok * 1024 + hd * 128;
    const float sc = isk ? 1.f : 0.125f * LOG2E;
#pragma unroll
    for (int i = 0; i < 8; ++i) {
#pragma unroll
      for (int e = 0; e < 8; ++e) v[i][e] *= sc;
      store8(D + 8 * (half + 2 * i), v[i]);
    }
  } else {
    const int hd = nt - 40;
    bf16_t* VT = (bf16_t*)(p.ws + O_DVT) + (size_t)(hd * 128) * TOK + tok;
#pragma unroll
    for (int i = 0; i < 8; ++i)
#pragma unroll
      for (int e = 0; e < 8; ++e) VT[(size_t)(8 * (half + 2 * i) + e) * TOK] = f2bf(v[i][e]);
  }
}


template <int NI> DI void inproj_epi_reg(const Params& p, int layer, int nt, int tok, int h, f32x16 (&acc)[4][2]) {
  const int tl = tok - 256, prow = (tl >> 6) & 127, pcol = tl & 63;
  const f32x2* TAB = (const f32x2*)(p.ws + O_TAB);
  const float* scal = (const float*)(p.ws + O_SCAL);
#define ST4(BASE) { _Pragma("unroll") for (int mi = 0; mi < 4; ++mi) _Pragma("unroll") for (int g = 0; g < 4; ++g) { \
      u32x2 o_; o_.x = pack2(acc[mi][NI][4 * g], acc[mi][NI][4 * g + 1]); o_.y = pack2(acc[mi][NI][4 * g + 2], acc[mi][NI][4 * g + 3]); *(u32x2*)((BASE) + 32 * mi + 8 * g + 4 * h) = o_; } }
#define STT(BASE, MUL) { bf16_t* q_ = (BASE) + (size_t)(4 * h) * TOK; _Pragma("unroll") for (int mi = 0; mi < 4; ++mi) _Pragma("unroll") for (int g = 0; g < 4; ++g) { \
      _Pragma("unroll") for (int e = 0; e < 4; ++e) q_[(size_t)e * TOK] = f2bf(acc[mi][NI][4 * g + e] * (MUL)); q_ += (size_t)8 * TOK; asm volatile("" : "+v"(q_)); } }
  if (nt < 4) {
#pragma unroll
    for (int mi = 0; mi < 4; ++mi)
#pragma unroll
      for (int reg = 0; reg < 16; ++reg) acc[mi][NI][reg] = gelu_tanh(acc[mi][NI][reg]);
    bf16_t* U = (bf16_t*)(p.ws + O_U) + (size_t)tok * 512 + nt * 128;
    ST4(U);
  } else if (nt < 8) {
    const int g_ = nt - 4;
    float ss = 0.f;
#pragma unroll
    for (int mi = 0; mi < 4; ++mi)
#pragma unroll
      for (int reg = 0; reg < 16; ++reg) { acc[mi][NI][reg] = gelu_tanh(acc[mi][NI][reg]); ss += acc[mi][NI][reg] * acc[mi][NI][reg]; }
    ss += __shfl_xor(ss, 32);
    const float rstd = rsqrtf(ss * (1.f / 128.f) + EPS);
    bf16_t* VNT = (bf16_t*)(p.ws + O_VNT) + (size_t)(g_ * NCH + (tok >> 7)) * 16384 + (tok & 127);
#pragma unroll
    for (int mi = 0; mi < 4; ++mi)
#pragma unroll
      for (int reg = 0; reg < 16; ++reg) VNT[(32 * mi + 8 * (reg >> 2) + 4 * h + (reg & 3)) * 128] = f2bf(acc[mi][NI][reg] * rstd);
  } else if (nt < 16) {
    const int isk = nt >= 12, hd = (nt - 8) & 3;
#pragma unroll
    for (int mi = 0; mi < 4; mi += 2) {
      const int pos = (mi == 0) ? prow : pcol;
#pragma unroll
      for (int reg = 0; reg < 16; ++reg) {
        const f32x2 cs = TAB[(8 * (reg >> 2) + 4 * h + (reg & 3)) * 128 + pos];
        const float x1 = acc[mi][NI][reg], x2 = acc[mi + 1][NI][reg];
        acc[mi][NI][reg] = x1 * cs.x - x2 * cs.y; acc[mi + 1][NI][reg] = x1 * cs.y + x2 * cs.x;
      }
    }
    if (!isk) {
      bf16_t* RQ = (bf16_t*)(p.ws + O_RQ) + (size_t)tok * 512 + hd * 128;
      ST4(RQ);
    } else {
      const float scale = 0.08838834764831845f;
      const float lgf = scal[layer * 8 + hd], lgb = scal[layer * 8 + 4 + hd];
      const int j = tok & 127;
      const float df = ex2((float)(127 - j) * lgf * LOG2E), db = ex2((float)j * lgb * LOG2E);
#pragma unroll
      for (int mi = 0; mi < 4; ++mi)
#pragma unroll
        for (int reg = 0; reg < 16; ++reg) acc[mi][NI][reg] *= scale;
      bf16_t* RK = (bf16_t*)(p.ws + O_RK) + (size_t)tok * 512 + hd * 128;
      ST4(RK);
      bf16_t* KF = (bf16_t*)(p.ws + O_RKTF) + (size_t)(hd * 128) * TOK + tok;
      bf16_t* KB = (bf16_t*)(p.ws + O_RKTB) + (size_t)(hd * 128) * TOK + tok;
      STT(KF, df);
      STT(KB, db);
    }
  } else if (nt < 20) {
    bf16_t* VT = (bf16_t*)(p.ws + O_RVT) + (size_t)((nt - 16) * 128) * TOK + tok;
    STT(VT, 1.f);
  } else if (nt < 24) {
#pragma unroll
    for (int mi = 0; mi < 4; ++mi)
#pragma unroll
      for (int reg = 0; reg < 16; ++reg) acc[mi][NI][reg] = silu(acc[mi][NI][reg]);
    bf16_t* RG = (bf16_t*)(p.ws + O_RG) + (size_t)tok * 512 + (nt - 20) * 128;
    ST4(RG);
  } else if (nt < 40) {
    const int isk = nt >= 32, hd = (nt - 24) & 7;
    const float sc = isk ? 1.f : 0.125f * LOG2E;
#pragma unroll
    for (int mi = 0; mi < 4; ++mi) {
      const int pos = (mi & 1) ? pcol : prow;
#pragma unroll
      for (int reg = 0; reg < 8; ++reg) {
        const f32x2 cs = TAB[2 * (8 * (reg >> 2) + 4 * h + (reg & 3)) * 128 + pos];
        const float x1 = acc[mi][NI][reg], x2 = acc[mi][NI][reg + 8];
        acc[mi][NI][reg] = (x1 * cs.x - x2 * cs.y) * sc; acc[mi][NI][reg + 8] = (x1 * cs.y + x2 * cs.x) * sc;
      }
    }
    bf16_t* D = (bf16_t*)(p.ws + (isk ? O_DK : O_DQ)) + (size_t)tok * 1024 + hd * 128;
    ST4(D);
  } else {
    bf16_t* VT = (bf16_t*)(p.ws + O_DVT) + (size_t)((nt - 40) * 128) * TOK + tok;
    STT(VT, 1.f);
  }
#undef ST4
#undef STT
}

DI void inproj_phase(const Params& p, int layer, char* smem) {
  const bf16_t* H = (const bf16_t*)(p.ws + O_H);
  const bf16_t* W = (const bf16_t*)(p.ws + O_WIN) + (size_t)layer * DIN * DM;
  for (int i = 0;; ++i) {
    const int L = tile_of(i, 32 * 24);
    if (L < 0) break;
    int tm, tn; tile_mn(L, 32, 24, tm, tn);
    f32x16 acc[4][2]; zero_acc256(acc);
    gemm256((const char*)(W + (size_t)(tn * 256) * DM), voff256(DM), (size_t)128 * DM, (const char*)(H + (size_t)(256 + tm * 256) * DM), voff256(DM), (size_t)128 * DM, DM / 64, smem, acc);
    const int t = tid512(), lane = t & 63, w = t >> 6, wm = w >> 2, wn = w & 3, r = lane & 31, h = lane >> 5;
    inproj_epi_reg<0>(p, layer, 2 * tn + wm, 256 + 256 * tm + 64 * wn + r, h, acc);
    inproj_epi_reg<1>(p, layer, 2 * tn + wm, 256 + 256 * tm + 64 * wn + 32 + r, h, acc);
  }
  char* sg = smem + grp() * GSM;
  const int nctx = (layer == 1) ? 48 : 96;
  for (int i = 0;; ++i) {
    const int L = item_of(i, nctx);
    if (L < 0) break;
    const int mt = L & 1, ix = L >> 1;
    const int nt = (layer == 1) ? (ix < 8 ? 12 + ix : 24 + ix) : ix;
    const bf16_t *ap[4], *bp[4];
    setup_ptrs(ap, H, DM, mt * 128); setup_ptrs(bp, W, DM, nt * 128);
    f32x16 acc[2][2]; zero_acc(acc);
    gemm_main(ap, bp, DM / 64, sg, acc);
    dump_ct<false>(acc, (float*)sg);
    __syncthreads();
    inproj_epi(p, layer, mt, nt, (const float*)sg);
  }
  if (layer == 0) idle_transposes(p, nctx >> 1, 2048, 4224, sg);
  else idle_transposes(p, nctx >> 1, 6272 + 4480, 1792, sg);
}

DI void attn_item(const Params& p, int layer, int hd, int q0, int nkeys, char* smem) {
  constexpr int KT = 64 * 272, ST = KT + 128 * 136;
  const int t = tid(), lane = t & 63, w = t >> 6, r = lane & 31, h = lane >> 5;
  const bf16_t* DQ = (const bf16_t*)(p.ws + O_DQ);
  const bf16_t* DK = (const bf16_t*)(p.ws + O_DK);
  const bf16_t* DVT = (const bf16_t*)(p.ws + O_DVT);
  const float* scal = (const float*)(p.ws + O_SCAL);
  const int q = q0 + 32 * w + r;
  bf16x8 qf[2][4];
#pragma unroll
  for (int mp = 0; mp < 2; ++mp)
#pragma unroll
    for (int s = 0; s < 4; ++s) qf[mp][s] = *(const bf16x8*)(DQ + (size_t)q * 1024 + hd * 128 + 64 * mp + 16 * s + 8 * h);
  const int nkb = nkeys >> 6;
  const bf16_t* kp = DK + (size_t)(t >> 4) * 1024 + hd * 128 + (t & 15) * 8;
  const int ksoff = (t >> 4) * 272 + (t & 15) * 16;
  const bf16_t* vp = DVT + (size_t)(hd * 128 + (t >> 3)) * TOK + (t & 7) * 8;
  const int vsoff = KT + (t >> 3) * 136 + (t & 7) * 16;
  u32x4 rk[4], rv[4];

  float m1 = -1e30f, l1 = 0.f, m2 = -1e30f, l2 = 0.f;
#pragma unroll
  for (int i = 0; i < 4; ++i) rk[i] = *(const u32x4*)(kp + (size_t)(16 * i) * 1024);
  __syncthreads();
#pragma unroll
  for (int i = 0; i < 4; ++i) *(u32x4*)(smem + ksoff + i * 16 * 272) = rk[i];
  __syncthreads();
  for (int kb = 0; kb < nkb; ++kb) {
    const int cur = kb & 1;
    const bool more = (kb + 1) < nkb;
    if (more) {
#pragma unroll
      for (int i = 0; i < 4; ++i) rk[i] = *(const u32x4*)(kp + (size_t)((kb + 1) * 64 + 16 * i) * 1024);
    }
    const char* Ks = smem + cur * ST;
#pragma unroll
    for (int kt = 0; kt < 2; ++kt) {
      f32x16 s1, s2;
#pragma unroll
      for (int i = 0; i < 16; ++i) { s1[i] = 0.f; s2[i] = 0.f; }
#pragma unroll
      for (int s = 0; s < 4; ++s) {
        const bf16x8 a1 = *(const bf16x8*)(Ks + (32 * kt + r) * 272 + 32 * s + 16 * h);
        const bf16x8 a2 = *(const bf16x8*)(Ks + (32 * kt + r) * 272 + 128 + 32 * s + 16 * h);
        s1 = MFMA32(a1, qf[0][s], s1);
        s2 = MFMA32(a2, qf[1][s], s2);
      }
      {
        float mx = s1[0];
#pragma unroll
        for (int i = 1; i < 16; ++i) mx = fmaxf(mx, s1[i]);
        const float mn = fmaxf(m1, mx * LOG2E);
        float sum = 0.f;
#pragma unroll
        for (int i = 0; i < 16; ++i) sum += ex2(s1[i] * LOG2E - mn);
        l1 = l1 * ex2(m1 - mn) + sum; m1 = mn;
      }
      {
        float mx = s2[0];
#pragma unroll
        for (int i = 1; i < 16; ++i) mx = fmaxf(mx, s2[i]);
        const float mn = fmaxf(m2, mx * LOG2E);
        float sum = 0.f;
#pragma unroll
        for (int i = 0; i < 16; ++i) sum += ex2(s2[i] * LOG2E - mn);
        l2 = l2 * ex2(m2 - mn) + sum; m2 = mn;
      }
    }
    if (more) {
      char* D = smem + (cur ^ 1) * ST;
#pragma unroll
      for (int i = 0; i < 4; ++i) *(u32x4*)(D + ksoff + i * 16 * 272) = rk[i];
    }
    __syncthreads();
  }
  float inv1, inv2;
  {
    const float mo = __shfl_xor(m1, 32), lo = __shfl_xor(l1, 32);
    const float M = fmaxf(m1, mo);
    const float Ls = l1 * ex2(m1 - M) + lo * ex2(mo - M);
    m1 = M; inv1 = 1.f / Ls;
  }
  {
    const float mo = __shfl_xor(m2, 32), lo = __shfl_xor(l2, 32);
    const float M = fmaxf(m2, mo);
    const float Ls = l2 * ex2(m2 - M) + lo * ex2(mo - M);
    m2 = M; inv2 = scal[16 + layer] / Ls;
  }

  f32x16 o[4];
#pragma unroll
  for (int vt = 0; vt < 4; ++vt)
#pragma unroll
    for (int i = 0; i < 16; ++i) o[vt][i] = 0.f;
#pragma unroll
  for (int i = 0; i < 4; ++i) { rk[i] = *(const u32x4*)(kp + (size_t)(16 * i) * 1024); rv[i] = *(const u32x4*)(vp + (size_t)(32 * i) * TOK); }
  __syncthreads();
#pragma unroll
  for (int i = 0; i < 4; ++i) {
    *(u32x4*)(smem + ksoff + i * 16 * 272) = rk[i];
    u32x2 lo2 = {rv[i].x, rv[i].y}, hi2 = {rv[i].z, rv[i].w};
    *(u32x2*)(smem + vsoff + i * 32 * 136) = lo2; *(u32x2*)(smem + vsoff + i * 32 * 136 + 8) = hi2;
  }
  __syncthreads();
  for (int kb = 0; kb < nkb; ++kb) {
    const int cur = kb & 1;
    const bool more = (kb + 1) < nkb;
    const char* Ks = smem + cur * ST;
    const char* Vs = Ks + KT;
    char* D = smem + (cur ^ 1) * ST;
    auto step = [&](const int kt) {
      f32x16 s1, s2;
#pragma unroll
      for (int i = 0; i < 16; ++i) { s1[i] = 0.f; s2[i] = 0.f; }
#pragma unroll
      for (int s = 0; s < 4; ++s) {
        const bf16x8 a1 = *(const bf16x8*)(Ks + (32 * kt + r) * 272 + 32 * s + 16 * h);
        const bf16x8 a2 = *(const bf16x8*)(Ks + (32 * kt + r) * 272 + 128 + 32 * s + 16 * h);
        s1 = MFMA32(a1, qf[0][s], s1);
        s2 = MFMA32(a2, qf[1][s], s2);
      }
#pragma unroll
      for (int s2i = 0; s2i < 2; ++s2i) {
        float pv[8];
#pragma unroll
        for (int i = 0; i < 8; ++i) pv[i] = ex2(s1[8 * s2i + i] * LOG2E - m1) * inv1 - ex2(s2[8 * s2i + i] * LOG2E - m2) * inv2;
        u32x4 pk; pk.x = pack2(pv[0], pv[1]); pk.y = pack2(pv[2], pv[3]); pk.z = pack2(pv[4], pv[5]); pk.w = pack2(pv[6], pv[7]);
        const bf16x8 pb = __builtin_bit_cast(bf16x8, pk);
#pragma unroll
        for (int vt = 0; vt < 4; ++vt) {
          const char* vrow = Vs + (32 * vt + r) * 136 + (32 * kt + 16 * s2i + 4 * h) * 2;
          const s16x4 lo = *(const s16x4*)vrow, hi = *(const s16x4*)(vrow + 16);
          const bf16x8 a = __builtin_shufflevector(lo, hi, 0, 1, 2, 3, 4, 5, 6, 7);
          o[vt] = MFMA32(a, pb, o[vt]);
        }
      }
    };
    if (more) {
#pragma unroll
      for (int i = 0; i < 4; ++i) rk[i] = *(const u32x4*)(kp + (size_t)((kb + 1) * 64 + 16 * i) * 1024);
    }
    step(0);
    if (more) {
#pragma unroll
      for (int i = 0; i < 4; ++i) *(u32x4*)(D + ksoff + i * 16 * 272) = rk[i];
#pragma unroll
      for (int i = 0; i < 4; ++i) rk[i] = *(const u32x4*)(vp + (size_t)(32 * i) * TOK + (kb + 1) * 64);
    }
    step(1);
    if (more) {
#pragma unroll
      for (int i = 0; i < 4; ++i) {
        u32x2 lo2 = {rk[i].x, rk[i].y}, hi2 = {rk[i].z, rk[i].w};
        *(u32x2*)(D + vsoff + i * 32 * 136) = lo2; *(u32x2*)(D + vsoff + i * 32 * 136 + 8) = hi2;
      }
    }
    __syncthreads();
  }
  float ss = 0.f;
#pragma unroll
  for (int vt = 0; vt < 4; ++vt)
#pragma unroll
    for (int i = 0; i < 16; ++i) ss += o[vt][i] * o[vt][i];
  ss += __shfl_xor(ss, 32);
  const float mul = rsqrtf(ss * (1.f / 128.f) + EPS) * (1.f - scal[18 + layer]);
  bf16_t* Y = (bf16_t*)(p.ws + O_Y) + (size_t)q * DM + 1024 + hd * 128;
  const float* sg = p.subln + layer * 128;
#pragma unroll
  for (int vt = 0; vt < 4; ++vt)
#pragma unroll
    for (int g = 0; g < 4; ++g) {
      const int vv = 32 * vt + 8 * g + 4 * h;
      const f32x4 gg = *(const f32x4*)(sg + vv);
      u32x2 ov; ov.x = pack2(o[vt][4 * g] * mul * gg.x, o[vt][4 * g + 1] * mul * gg.y);
      ov.y = pack2(o[vt][4 * g + 2] * mul * gg.z, o[vt][4 * g + 3] * mul * gg.w);
      *(u32x2*)(Y + vv) = ov;
    }
}


DI void attn_block(const Params& p, int layer, int hd, int q0, int nkeys, char* smem) {
  constexpr int KT = 64 * 272, VROW = 144, ST = KT + 128 * VROW;
  const int t = tid512(), lane = t & 63, w = t >> 6, mp = w >> 2, wq = w & 3, r = lane & 31, h = lane >> 5;
  const bf16_t* DQ = (const bf16_t*)(p.ws + O_DQ);
  const bf16_t* DK = (const bf16_t*)(p.ws + O_DK);
  const bf16_t* DVT = (const bf16_t*)(p.ws + O_DVT);
  const float* scal = (const float*)(p.ws + O_SCAL);
  const int q = q0 + 32 * wq + r;
  bf16x8 qf[4];
#pragma unroll
  for (int s = 0; s < 4; ++s) qf[s] = *(const bf16x8*)(DQ + (size_t)q * 1024 + hd * 128 + 64 * mp + 16 * s + 8 * h);
  const int nkb = nkeys >> 6, lastkb = nkb - 1;
  const bf16_t* kp = DK + (size_t)(t >> 4) * 1024 + hd * 128 + (t & 15) * 8;
  const int ksoff = (t >> 4) * 272 + (t & 15) * 16;
  const bf16_t* vp = DVT + (size_t)(hd * 128 + (t >> 3)) * TOK + (t & 7) * 8;
  const int vsoff = KT + (t >> 3) * VROW + ((t & 7) >> 1) * 32 + (t & 1) * 8;
  u32x4 rk[2], rv[2];
#define A_LOAD(KB) { _Pragma("unroll") for (int i = 0; i < 2; ++i) { rk[i] = *(const u32x4*)(kp + (size_t)((KB) * 64 + 32 * i) * 1024); rv[i] = *(const u32x4*)(vp + (size_t)(64 * i) * TOK + (KB) * 64); } }
#define A_STORE(STG) { char* D_ = smem + (STG) * ST; _Pragma("unroll") for (int i = 0; i < 2; ++i) { *(u32x4*)(D_ + ksoff + i * 32 * 272) = rk[i]; \
      u32x2 lo2_ = {rv[i].x, rv[i].y}, hi2_ = {rv[i].z, rv[i].w}; *(u32x2*)(D_ + vsoff + i * 64 * VROW) = lo2_; *(u32x2*)(D_ + vsoff + i * 64 * VROW + 16) = hi2_; } }
#define A_SCORES(DST, STG) { const char* Ks_ = smem + (STG) * ST; _Pragma("unroll") for (int kt = 0; kt < 2; ++kt) { \
      _Pragma("unroll") for (int i = 0; i < 16; ++i) DST[kt][i] = 0.f; \
      _Pragma("unroll") for (int s = 0; s < 4; ++s) { const bf16x8 a_ = *(const bf16x8*)(Ks_ + (32 * kt + r) * 272 + 128 * mp + 32 * s + 16 * h); DST[kt] = MFMA32(a_, qf[s], DST[kt]); } } }
  A_LOAD(0);
  __syncthreads();
  A_STORE(0);
  A_LOAD(lastkb < 1 ? lastkb : 1);
  A_STORE(1);
  A_LOAD(lastkb < 2 ? lastkb : 2);
  __syncthreads();
  float m = -1e30f, l = 0.f;
  f32x16 o[4];
#pragma unroll
  for (int vt = 0; vt < 4; ++vt)
#pragma unroll
    for (int i = 0; i < 16; ++i) o[vt][i] = 0.f;
  f32x16 sc[2], sn[2];
  A_SCORES(sc, 0);
  int c0 = 0, c1 = 1, c2 = 2;
  for (int kb = 0; kb < nkb; ++kb) {
    const char* Vs = smem + c0 * ST + KT;
    A_STORE(c2);
    A_LOAD((kb + 3 < lastkb) ? kb + 3 : lastkb);
    if (kb + 1 < nkb) A_SCORES(sn, c1);
    float mx = fmaxf(sc[0][0], sc[1][0]);
#pragma unroll
    for (int i = 1; i < 16; ++i) mx = fmaxf(mx, fmaxf(sc[0][i], sc[1][i]));
    {
      const auto pr_ = __builtin_amdgcn_permlane32_swap(__float_as_uint(mx), __float_as_uint(mx), false, false);
      mx = fmaxf(__uint_as_float(pr_[0]), __uint_as_float(pr_[1]));
    }
    if (__any(mx > m + 8.f)) {
      const float mn = (mx > m + 8.f) ? mx : m;
      const float alpha = ex2(m - mn);
      l *= alpha;
#pragma unroll
      for (int vt = 0; vt < 4; ++vt)
#pragma unroll
        for (int i = 0; i < 16; ++i) o[vt][i] *= alpha;
      m = mn;
    }
    bf16x8 va[2][4];
    const char* vbase = Vs + r * VROW + 16 * h;
#pragma unroll
    for (int vt = 0; vt < 4; ++vt) va[0][vt] = *(const bf16x8*)(vbase + 32 * vt * VROW);
    float ls[4] = {0.f, 0.f, 0.f, 0.f};
#pragma unroll
    for (int st = 0; st < 4; ++st) {
      if (st < 3) {
#pragma unroll
        for (int vt = 0; vt < 4; ++vt) va[(st + 1) & 1][vt] = *(const bf16x8*)(vbase + 32 * vt * VROW + (st + 1) * 32);
      }
      float pv[8];
#pragma unroll
      for (int i = 0; i < 8; ++i) { pv[i] = ex2(sc[st >> 1][8 * (st & 1) + i] - m); ls[i & 3] += pv[i]; }
      u32x4 pk; pk.x = pack2(pv[0], pv[1]); pk.y = pack2(pv[2], pv[3]); pk.z = pack2(pv[4], pv[5]); pk.w = pack2(pv[6], pv[7]);
      const bf16x8 pb = __builtin_bit_cast(bf16x8, pk);
#pragma unroll
      for (int vt = 0; vt < 4; ++vt) o[vt] = MFMA32(va[st & 1][vt], pb, o[vt]);
    }
    l += (ls[0] + ls[1]) + (ls[2] + ls[3]);
    __syncthreads();
    sc[0] = sn[0]; sc[1] = sn[1];
    { const int tmp = c0; c0 = c1; c1 = c2; c2 = tmp; }
  }
#undef A_SCORES
#undef A_LOAD
#undef A_STORE
  l += __shfl_xor(l, 32);
  const float scl = (mp == 0 ? 1.f : scal[16 + layer]) / l;
  float* Xc = (float*)smem;
  const int xrow = (32 * wq + r) * CTS;
  if (mp == 1) {
#pragma unroll
    for (int vt = 0; vt < 4; ++vt)
#pragma unroll
      for (int g = 0; g < 4; ++g) {
        f32x4 v4 = {o[vt][4 * g] * scl, o[vt][4 * g + 1] * scl, o[vt][4 * g + 2] * scl, o[vt][4 * g + 3] * scl};
        *(f32x4*)(Xc + xrow + 32 * vt + 8 * g + 4 * h) = v4;
      }
  }
  __syncthreads();
  if (mp == 0) {
    float ss = 0.f;
#pragma unroll
    for (int vt = 0; vt < 4; ++vt)
#pragma unroll
      for (int g = 0; g < 4; ++g) {
        const f32x4 x4 = *(const f32x4*)(Xc + xrow + 32 * vt + 8 * g + 4 * h);
        o[vt][4 * g] = o[vt][4 * g] * scl - x4.x; o[vt][4 * g + 1] = o[vt][4 * g + 1] * scl - x4.y;
        o[vt][4 * g + 2] = o[vt][4 * g + 2] * scl - x4.z; o[vt][4 * g + 3] = o[vt][4 * g + 3] * scl - x4.w;
        ss += o[vt][4 * g] * o[vt][4 * g] + o[vt][4 * g + 1] * o[vt][4 * g + 1] + o[vt][4 * g + 2] * o[vt][4 * g + 2] + o[vt][4 * g + 3] * o[vt][4 * g + 3];
      }
    ss += __shfl_xor(ss, 32);
    const float mul = rsqrtf(ss * (1.f / 128.f) + EPS) * (1.f - scal[18 + layer]);
    bf16_t* Y = (bf16_t*)(p.ws + O_Y) + (size_t)q * DM + 1024 + hd * 128;
    const float* sg = p.subln + layer * 128;
#pragma unroll
    for (int vt = 0; vt < 4; ++vt)
#pragma unroll
      for (int g = 0; g < 4; ++g) {
        const int vv = 32 * vt + 8 * g + 4 * h;
        const f32x4 gg = *(const f32x4*)(sg + vv);
        u32x2 ov; ov.x = pack2(o[vt][4 * g] * mul * gg.x, o[vt][4 * g + 1] * mul * gg.y);
        ov.y = pack2(o[vt][4 * g + 2] * mul * gg.z, o[vt][4 * g + 3] * mul * gg.w);
        *(u32x2*)(Y + vv) = ov;
      }
  }
  __syncthreads();
}

DI void mix_phase(const Params& p, int layer, char* smem_blk, char* smem) {
  for (int i = 0;; ++i) {
    const int it = tile_of(i, 512);
    if (it < 0) break;
    attn_block(p, layer, it >> 6, 256 + 128 * (it & 63), TOK, smem_blk);
  }
  if (layer == 0) {
    for (int i = 0;; ++i) {
      const int it = tile_of(i, 16);
      if (it < 0) break;
      attn_block(p, layer, it >> 1, 128 * (it & 1), 256, smem_blk);
    }
  }
  const int c0 = layer == 0 ? 0 : 2;
  const int nS = (NCH - c0) * 4, nR = NCH * 8;
  for (int i = 0;; ++i) {
    const int it = item_of(i, nS + nR);
    if (it < 0) break;
    const int t = tid(), lane = t & 63, w = t >> 6, wm = w >> 1, wn = w & 1, r = lane & 31, h = lane >> 5;
    const bf16_t *ap[4], *bp[4];
    f32x16 acc[2][2]; zero_acc(acc);
    if (it < nS) {
      const int g = it & 3, n = c0 + (it >> 2);
      setup_ptrs(ap, (const bf16_t*)(p.ws + O_SW) + (size_t)(layer * 4 + g) * 16384, 128, 0);
      setup_ptrs(bp, (const bf16_t*)(p.ws + O_VNT) + (size_t)(g * NCH + n) * 16384, 128, 0);
      gemm_main(ap, bp, 2, smem, acc);
      const bf16_t* U = (const bf16_t*)(p.ws + O_U);
      bf16_t* Y = (bf16_t*)(p.ws + O_Y);
      const float* sb = p.sgu_b + (layer * 4 + g) * 128;
#pragma unroll
      for (int mi = 0; mi < 2; ++mi)
#pragma unroll
        for (int ni = 0; ni < 2; ++ni)
#pragma unroll
          for (int reg = 0; reg < 16; ++reg) {
            const int ii = 64 * wm + 32 * mi + (reg & 3) + 8 * (reg >> 2) + 4 * h, cc = 64 * wn + 32 * ni + r;
            const size_t tok = (size_t)n * 128 + ii;
            const unsigned uu = U[tok * 512 + g * 128 + cc];
            const float uf = __uint_as_float(uu << 16);
            Y[tok * DM + g * 128 + cc] = f2bf(uf * (acc[mi][ni][reg] + sb[ii]));
          }
    } else {
      const int j = it - nS, n = j % NCH, dh = j / NCH, dir = dh >> 2, hd = dh & 3;
      setup_ptrs(ap, (const bf16_t*)(p.ws + O_RVT) + (size_t)n * 128, TOK, hd * 128);
      setup_ptrs(bp, (const bf16_t*)(p.ws + (dir ? O_RKTB : O_RKTF)) + (size_t)n * 128, TOK, hd * 128);
      gemm_main(ap, bp, 2, smem, acc);
      float* UT = (float*)(p.ws + O_UT) + (size_t)(dh * NCH + n) * 16384;
#pragma unroll
      for (int mi = 0; mi < 2; ++mi)
#pragma unroll
        for (int ni = 0; ni < 2; ++ni)
#pragma unroll
          for (int reg = 0; reg < 16; ++reg) {
            const int vv = 64 * wm + 32 * mi + (reg & 3) + 8 * (reg >> 2) + 4 * h, dd = 64 * wn + 32 * ni + r;
            UT[vv * 128 + dd] = acc[mi][ni][reg];
          }
    }
  }
}

DI void scan_phase(const Params& p, int layer, char* smem) {
  const float* scal = (const float*)(p.ws + O_SCAL);
  const float* UT = (const float*)(p.ws + O_UT);
  bf16_t* ST = (bf16_t*)(p.ws + O_ST);
  for (int e = blockIdx.x * 512 + threadIdx.x; e < 8 * 16384; e += gridDim.x * 512) {
    const int dh = e >> 14, idx = e & 16383, dir = dh >> 2, hd = dh & 3;
    const float cdec = ex2(128.f * scal[layer * 8 + dir * 4 + hd] * LOG2E);
    float S = 0.f;
    for (int p0 = 0; p0 < NCH; p0 += 22) {
      float u[22];
#pragma unroll
      for (int k = 0; k < 22; ++k) {
        const int pp = p0 + k;
        const int n = dir == 0 ? pp : (pp < 2 ? 1 - pp : 67 - pp);
        u[k] = __builtin_nontemporal_load(UT + (size_t)(dh * NCH + n) * 16384 + idx);
      }
#pragma unroll
      for (int k = 0; k < 22; ++k) {
        const int pp = p0 + k;
        const int n = dir == 0 ? pp : (pp < 2 ? 1 - pp : 67 - pp);
        ST[(size_t)(dh * NCH + n) * 16384 + idx] = f2bf(S);
        S = S * cdec + u[k];
      }
    }
  }
  if (layer == 0) transpose_range(p, 6272 + 2048, 1216, blockIdx.x, gridDim.x, smem);
}

DI void retc_phase(const Params& p, int layer, char* smem) {
  const int c0 = layer == 0 ? 0 : 2;
  const int nI = (NCH - c0) * 4;
  const float* scal = (const float*)(p.ws + O_SCAL);
  bf16_t* Ps = (bf16_t*)(p.ws + O_PS) + (size_t)(2 * blockIdx.x + grp()) * 16384;
  for (int i = 0;; ++i) {
    const int it = item_of(i, nI);
    if (it < 0) break;
    const int t = tid(), lane = t & 63, w = t >> 6, wm = w >> 1, wn = w & 1, r = lane & 31, h = lane >> 5;
    const int hd = it & 3, n = c0 + (it >> 2);
    const float lgf = scal[layer * 8 + hd] * LOG2E, lgb = scal[layer * 8 + 4 + hd] * LOG2E;
    const bf16_t *ap[4], *bp[4];
    const bf16_t* RQ = (const bf16_t*)(p.ws + O_RQ) + (size_t)n * 128 * 512 + hd * 128;
    setup_ptrs(bp, RQ, 512, 0);
    {
      f32x16 sacc[2][2]; zero_acc(sacc);
      setup_ptrs(ap, (const bf16_t*)(p.ws + O_RK) + (size_t)n * 128 * 512 + hd * 128, 512, 0);
      gemm_main(ap, bp, 2, smem, sacc);
#pragma unroll
      for (int mi = 0; mi < 2; ++mi)
#pragma unroll
        for (int ni = 0; ni < 2; ++ni) {
          const int ii = 64 * wn + 32 * ni + r;
#pragma unroll
          for (int g = 0; g < 4; ++g) {
            float pv[4];
#pragma unroll
            for (int e = 0; e < 4; ++e) {
              const int jj = 64 * wm + 32 * mi + 8 * g + 4 * h + e;
              const float d = (ii > jj) ? ex2((float)(ii - jj) * lgf) : ((ii < jj) ? ex2((float)(jj - ii) * lgb) : 2.f);
              pv[e] = sacc[mi][ni][4 * g + e] * d;
            }
            u32x2 o; o.x = pack2(pv[0], pv[1]); o.y = pack2(pv[2], pv[3]);
            *(u32x2*)(Ps + ii * 128 + 64 * wm + 32 * mi + 8 * g + 4 * h) = o;
          }
        }
    }
    f32x16 acc[2][2]; zero_acc(acc);
    setup_ptrs(ap, (const bf16_t*)(p.ws + O_ST) + (size_t)((0 * 4 + hd) * NCH + n) * 16384, 128, 0);
    gemm_main(ap, bp, 2, smem, acc);
#pragma unroll
    for (int ni = 0; ni < 2; ++ni) {
      const int ii = 64 * wn + 32 * ni + r;
      const float f = ex2((float)(ii + 1) * lgf - (float)(128 - ii) * lgb);
#pragma unroll
      for (int mi = 0; mi < 2; ++mi)
#pragma unroll
        for (int reg = 0; reg < 16; ++reg) acc[mi][ni][reg] *= f;
    }
    setup_ptrs(ap, (const bf16_t*)(p.ws + O_ST) + (size_t)((1 * 4 + hd) * NCH + n) * 16384, 128, 0);
    gemm_main(ap, bp, 2, smem, acc);
#pragma unroll
    for (int ni = 0; ni < 2; ++ni) {
      const int ii = 64 * wn + 32 * ni + r;
      const float f = ex2((float)(128 - ii) * lgb);
#pragma unroll
      for (int mi = 0; mi < 2; ++mi)
#pragma unroll
        for (int reg = 0; reg < 16; ++reg) acc[mi][ni][reg] *= f;
    }
    __syncthreads();
    setup_ptrs(ap, (const bf16_t*)(p.ws + O_RVT) + (size_t)n * 128, TOK, hd * 128);
    setup_ptrs(bp, Ps, 128, 0);
    gemm_main(ap, bp, 2, smem, acc);
    dump_ct<true>(acc, (float*)smem);
    __syncthreads();
    {
      const int rr = lane & 31, half = lane >> 5, lrow = 32 * w + rr;
      const size_t tok = (size_t)n * 128 + lrow;
      const float* Ct = (const float*)smem;
      float v[8][8];
      float ss = 0.f;
#pragma unroll
      for (int k = 0; k < 8; ++k) {
        const f32x4 a = *(const f32x4*)(Ct + lrow * CTS + 8 * (half + 2 * k));
        const f32x4 b = *(const f32x4*)(Ct + lrow * CTS + 8 * (half + 2 * k) + 4);
        v[k][0] = a.x; v[k][1] = a.y; v[k][2] = a.z; v[k][3] = a.w; v[k][4] = b.x; v[k][5] = b.y; v[k][6] = b.z; v[k][7] = b.w;
#pragma unroll
        for (int e = 0; e < 8; ++e) ss += v[k][e] * v[k][e];
      }
      ss += __shfl_xor(ss, 32);
      const float rstd = rsqrtf(ss * (1.f / 128.f) + EPS);
      const bf16_t* RG = (const bf16_t*)(p.ws + O_RG) + tok * 512 + hd * 128;
      bf16_t* Y = (bf16_t*)(p.ws + O_Y) + tok * DM + 512 + hd * 128;
#pragma unroll
      for (int k = 0; k < 8; ++k) {
        const u32x4 gv = *(const u32x4*)(RG + 8 * (half + 2 * k));
        const unsigned gw[4] = {gv.x, gv.y, gv.z, gv.w};
#pragma unroll
        for (int e = 0; e < 8; ++e) {
          const float gf = __uint_as_float((e & 1) ? (gw[e >> 1] & 0xffff0000u) : (gw[e >> 1] << 16));
          v[k][e] = v[k][e] * rstd * gf;
        }
        store8(Y + 8 * (half + 2 * k), v[k]);
      }
    }
  }
  if (layer == 0) idle_transposes(p, nI >> 1, 6272, 2048, smem);
}

DI void outproj_phase(const Params& p, int layer, char* smem) {
  if (layer != 0) return;
  const bf16_t* Yb = (const bf16_t*)(p.ws + O_Y);
  const bf16_t* W = (const bf16_t*)(p.ws + O_WOUT) + (size_t)layer * DM * DM;
  const float* g1 = (const float*)(p.ws + O_MODS) + (size_t)(layer * 2 + 1) * 12288 + 2 * DM;
  float* X = (float*)(p.ws + O_X);
  for (int i = 0;; ++i) {
    const int it = item_of(i, 128);
    if (it < 0) break;
    const int t = tid(), lane = t & 63, w = t >> 6, wm = w >> 1, wn = w & 1, r = lane & 31, h = lane >> 5;
    const int L = it >> 2, ks = it & 3, mt = L & 1, nt = L >> 1;
    const bf16_t *ap[4], *bp[4];
    setup_ptrs(ap, Yb + ks * 512, DM, mt * 128); setup_ptrs(bp, W + ks * 512, DM, nt * 128);
    f32x16 acc[2][2]; zero_acc(acc);
    gemm_main(ap, bp, 8, smem, acc);
#pragma unroll
    for (int mi = 0; mi < 2; ++mi)
#pragma unroll
      for (int ni = 0; ni < 2; ++ni) {
        const int col = nt * 128 + 64 * wn + 32 * ni + r;
        const float gg = g1[col];
#pragma unroll
        for (int reg = 0; reg < 16; ++reg) {
          const int row = mt * 128 + 64 * wm + 32 * mi + (reg & 3) + 8 * (reg >> 2) + 4 * h;
          unsafeAtomicAdd(&X[(size_t)row * DM + col], gg * acc[mi][ni][reg]);
        }
      }
  }
}

DI void gateup_phase(const Params& p, int layer, char* smem) {
  if (layer != 0) return;
  const int mt0 = 0, nM = 2;
  const bf16_t* H = (const bf16_t*)(p.ws + O_H);
  const bf16_t* WG = (const bf16_t*)(p.ws + O_WG) + (size_t)layer * DFF * DM;
  const bf16_t* WU = (const bf16_t*)(p.ws + O_WU) + (size_t)layer * DFF * DM;
  bf16_t* HID = (bf16_t*)(p.ws + O_HID);
  for (int i = 0;; ++i) {
    const int L = item_of_rot(i, nM * 88);
    if (L < 0) break;
    const int t = tid(), lane = t & 63, w = t >> 6, wm = w >> 1, wn = w & 1, r = lane & 31, h = lane >> 5;
    int mt, nb; tile_mn(L, nM, 88, mt, nb); mt += mt0;
    const bf16_t *ap[4], *bp[4];
    setup_ptrs(ap, H, DM, mt * 128);
#pragma unroll
    for (int k = 0; k < 4; ++k) {
      const int rho = (t >> 3) + 32 * k;
      const int col = nb * 64 + 32 * (rho >> 6) + (rho & 31);
      bp[k] = (((rho >> 5) & 1) ? WU : WG) + (size_t)col * DM + (t & 7) * 8;
    }
    f32x16 acc[2][2]; zero_acc(acc);
    gemm_main(ap, bp, DM / 64, smem, acc);
#pragma unroll
    for (int mi = 0; mi < 2; ++mi)
#pragma unroll
      for (int reg = 0; reg < 16; ++reg) {
        const int row = mt * 128 + 64 * wm + 32 * mi + (reg & 3) + 8 * (reg >> 2) + 4 * h;
        const int col = nb * 64 + 32 * wn + r;
        HID[(size_t)row * DFF + col] = f2bf(silu(acc[mi][0][reg]) * acc[mi][1][reg]);
      }
  }
}

DI void down_phase(const Params& p, int layer, char* smem) {
  if (layer != 0) return;
  const bf16_t* HID = (const bf16_t*)(p.ws + O_HID);
  const bf16_t* W = (const bf16_t*)(p.ws + O_WD) + (size_t)layer * DM * DFF;
  const float* g2 = (const float*)(p.ws + O_MODS) + (size_t)(layer * 2 + 1) * 12288 + 5 * DM;
  float* X = (float*)(p.ws + O_X);
  for (int i = 0;; ++i) {
    const int it = item_of(i, 128);
    if (it < 0) break;
    const int t = tid(), lane = t & 63, w = t >> 6, wm = w >> 1, wn = w & 1, r = lane & 31, h = lane >> 5;
    const int L = it >> 2, ks = it & 3, mt = L & 1, nt = L >> 1;
    const bf16_t *ap[4], *bp[4];
    setup_ptrs(ap, HID + ks * 1408, DFF, mt * 128); setup_ptrs(bp, W + ks * 1408, DFF, nt * 128);
    f32x16 acc[2][2]; zero_acc(acc);
    gemm_main(ap, bp, 22, smem, acc);
#pragma unroll
    for (int mi = 0; mi < 2; ++mi)
#pragma unroll
      for (int ni = 0; ni < 2; ++ni) {
        const int col = nt * 128 + 64 * wn + 32 * ni + r;
        const float gg = g2[col];
#pragma unroll
        for (int reg = 0; reg < 16; ++reg) {
          const int row = mt * 128 + 64 * wm + 32 * mi + (reg & 3) + 8 * (reg >> 2) + 4 * h;
          unsafeAtomicAdd(&X[(size_t)row * DM + col], gg * acc[mi][ni][reg]);
        }
      }
  }
  idle_transposes(p, 64, 6272 + 2048 + 1216, 1216, smem);
}

DI void outproj256(const Params& p, int layer, char* smem) {
  const bf16_t* Yb = (const bf16_t*)(p.ws + O_Y);
  const bf16_t* W = (const bf16_t*)(p.ws + O_WOUT) + (size_t)layer * DM * DM;
  const float* g1 = (const float*)(p.ws + O_MODS) + (size_t)(layer * 2) * 12288 + 2 * DM;
  float* X = (float*)(p.ws + O_X);
  for (int i = 0;; ++i) {
    const int L = tile_of(i, 32 * 8);
    if (L < 0) break;
    int tm, tn; tile_mn(L, 32, 8, tm, tn);
    f32x16 acc[4][2]; zero_acc256(acc);
    gemm256((const char*)(Yb + (size_t)(256 + tm * 256) * DM), voff256(DM), (size_t)128 * DM, (const char*)(W + (size_t)(tn * 256) * DM), voff256(DM), (size_t)128 * DM, DM / 64, smem, acc);
    const int t = tid512(), lane = t & 63, w = t >> 6, wm = w >> 2, wn = w & 3, r = lane & 31, h = lane >> 5;
#pragma unroll
    for (int mi = 0; mi < 4; ++mi)
#pragma unroll
      for (int ni = 0; ni < 2; ++ni) {
        const int col = tn * 256 + 64 * wn + 32 * ni + r;
        const float gg = g1[col];
#pragma unroll
        for (int reg = 0; reg < 16; ++reg) {
          const int row = 256 + tm * 256 + 128 * wm + 32 * mi + (reg & 3) + 8 * (reg >> 2) + 4 * h;
          const float res = (layer == 0) ? __builtin_nontemporal_load(p.x + (size_t)(row - 256) * DM + col) : X[(size_t)row * DM + col];
          X[(size_t)row * DM + col] = res + gg * acc[mi][ni][reg];
        }
      }
  }
}

DI void gateup256(const Params& p, int layer, char* smem) {
  const bf16_t* H = (const bf16_t*)(p.ws + O_H);
  const bf16_t* WG = (const bf16_t*)(p.ws + O_WG) + (size_t)layer * DFF * DM;
  const bf16_t* WU = (const bf16_t*)(p.ws + O_WU) + (size_t)layer * DFF * DM;
  bf16_t* HID = (bf16_t*)(p.ws + O_HID);
  for (int i = 0;; ++i) {
    const int L = tile_of(i, 32 * 44);
    if (L < 0) break;
    int tm, nb; tile_mn(L, 32, 44, tm, nb);
    const int t = tid512(), lane = t & 63, w = t >> 6, wm = w >> 2, wn = w & 3, r = lane & 31, h = lane >> 5;
    const unsigned bvo = (unsigned)(((size_t)((t >> 3) & 31) * DM + (t & 7) * 8) * 2 + ((((t >> 3) >> 5) & 1) ? (O_WU - O_WG) : 0));
    f32x16 acc[4][2]; zero_acc256(acc);
    gemm256((const char*)(H + (size_t)(256 + tm * 256) * DM), voff256(DM), (size_t)128 * DM, (const char*)(WG + (size_t)(nb * 128) * DM), bvo, (size_t)64 * DM, DM / 64, smem, acc);
#pragma unroll
    for (int mi = 0; mi < 4; ++mi)
#pragma unroll
      for (int reg = 0; reg < 16; ++reg) {
        const int row = 256 + tm * 256 + 128 * wm + 32 * mi + (reg & 3) + 8 * (reg >> 2) + 4 * h;
        const int col = nb * 128 + 32 * wn + r;
        HID[(size_t)row * DFF + col] = f2bf(silu(acc[mi][0][reg]) * acc[mi][1][reg]);
      }
  }
}

DI void down256(const Params& p, int layer, char* smem) {
  const bf16_t* HID = (const bf16_t*)(p.ws + O_HID);
  const bf16_t* W = (const bf16_t*)(p.ws + O_WD) + (size_t)layer * DM * DFF;
  const float* g2 = (const float*)(p.ws + O_MODS) + (size_t)(layer * 2) * 12288 + 5 * DM;
  float* X = (float*)(p.ws + O_X);
  for (int i = 0;; ++i) {
    const int L = tile_of(i, 32 * 8);
    if (L < 0) break;
    int tm, tn; tile_mn(L, 32, 8, tm, tn);
    f32x16 acc[4][2]; zero_acc256(acc);
    gemm256((const char*)(HID + (size_t)(256 + tm * 256) * DFF), voff256(DFF), (size_t)128 * DFF, (const char*)(W + (size_t)(tn * 256) * DFF), voff256(DFF), (size_t)128 * DFF, DFF / 64, smem, acc);
    const int t = tid512(), lane = t & 63, w = t >> 6, wm = w >> 2, wn = w & 3, r = lane & 31, h = lane >> 5;
#pragma unroll
    for (int mi = 0; mi < 4; ++mi)
#pragma unroll
      for (int ni = 0; ni < 2; ++ni) {
        const int col = tn * 256 + 64 * wn + 32 * ni + r;
        const float gg = g2[col];
#pragma unroll
        for (int reg = 0; reg < 16; ++reg) {
          const int row = 256 + tm * 256 + 128 * wm + 32 * mi + (reg & 3) + 8 * (reg >> 2) + 4 * h;
          X[(size_t)row * DM + col] += gg * acc[mi][ni][reg];
        }
      }
  }
}

__global__ void __launch_bounds__(512) mega(Params p) {
  extern __shared__ __attribute__((aligned(16))) char smem[];
  char* sg = smem + grp() * GSM;
  __shared__ uint4 xb_words;
  unsigned* barw = (unsigned*)(p.ws + O_BAR);
  if (threadIdx.x == 0) xb_words = make_uint4(0u, 0u, 0u, 0u);
  __syncthreads();
  const XcdBarrier xb = xcd_barrier_post(barw, (volatile LAS unsigned*)&xb_words);
  for (int layer = 0; layer < 2; ++layer) {
    if (layer == 0) phase0(p, sg);
    xcd_barrier(xb);
    norm_phase(p, layer, 0);
    xcd_barrier(xb);
    inproj_phase(p, layer, smem);
    xcd_barrier(xb);
#if DUP == 1
    inproj_phase(p, layer, smem);
    xcd_barrier(xb);
#endif
    mix_phase(p, layer, smem, sg);
    xcd_barrier(xb);
#if DUP == 2
    mix_phase(p, layer, smem, sg);
    xcd_barrier(xb);
#endif
    scan_phase(p, layer, sg);
    xcd_barrier(xb);
#if DUP == 7
    scan_phase(p, layer, sg);
    xcd_barrier(xb);
#endif
#if DUP == 8
    for (int q = 0; q < 10; ++q) xcd_barrier(xb);
#endif
    retc_phase(p, layer, sg);
    xcd_barrier(xb);
#if DUP == 3
    retc_phase(p, layer, sg);
    xcd_barrier(xb);
#endif
    outproj256(p, layer, smem);
    outproj_phase(p, layer, sg);
    xcd_barrier(xb);
    norm_phase(p, layer, 1);
    xcd_barrier(xb);
    gateup256(p, layer, smem);
    gateup_phase(p, layer, sg);
    xcd_barrier(xb);
#if DUP == 4
    gateup256(p, layer, smem);
    xcd_barrier(xb);
#endif
    down256(p, layer, smem);
    down_phase(p, layer, sg);
  }
  xcd_barrier(xb);
  norm_phase(p, 1, 2);
}

extern "C" void kernel_launch(void* const* d_in, const int* in_sizes, int n_in, void* d_out, int out_size, void* d_ws, size_t ws_size,
                              hipStream_t stream) {
  static int grid_blocks = 0;
  if (!grid_blocks) {
    if (ws_size < WS_END) { fprintf(stderr, "kernel_launch: workspace too small: %zu < %zu\n", ws_size, (size_t)WS_END); grid_blocks = -1; return; }
    int dev = 0, cus = 0, per_cu = 0;
    hipGetDevice(&dev);
    hipDeviceGetAttribute(&cus, hipDeviceAttributeMultiprocessorCount, dev);
    hipFuncSetAttribute((const void*)mega, hipFuncAttributeMaxDynamicSharedMemorySize, SMEM_BYTES);
    hipOccupancyMaxActiveBlocksPerMultiprocessor(&per_cu, (const void*)mega, 512, SMEM_BYTES);
    if (per_cu < 1) { fprintf(stderr, "kernel_launch: occupancy query returned %d\n", per_cu); grid_blocks = -1; return; }
    if (per_cu > 1) per_cu = 1;
    grid_blocks = cus * per_cu;
    if (grid_blocks > 512) grid_blocks = 512;
  }
  if (grid_blocks < 0) return;
  Params p{};
  const float** f = (const float**)&p;
  for (int i = 0; i < 23; ++i) f[i] = (const float*)d_in[i];
  p.out = (float*)d_out;
  p.ws = (char*)d_ws;
  (void)hipMemsetAsync((char*)d_ws + O_BAR, 0, XCD_BAR_WORDS * 4, stream);
  void* args[] = {&p};
  hipError_t e = hipLaunchCooperativeKernel((const void*)mega, dim3(grid_blocks), dim3(512), args, SMEM_BYTES, stream);
  if (e != hipSuccess) fprintf(stderr, "cooperative launch failed: %s (grid %d)\n", hipGetErrorString(e), grid_blocks);
}
```
